# Optimizing an MI355X kernel written in HIP

```python
import math, functools
import jax
import jax.numpy as jnp
from jax import lax
import numpy as np

D_MODEL = 1024
BATCH = 8
SEQ = 4096
DEPTH = 1

CTX_LEN = 256
GRID_W = 64
D_MIX = D_MODEL
D_RWKV = D_MIX // 2
D_S5 = D_MIX - D_RWKV
HEAD_DIM = 64
N_HEADS = D_RWKV // HEAD_DIM
LORA_W = 64
LORA_A = 64
N_DIR = 2
S5_GROUP = 16
N_GROUPS = D_S5 // S5_GROUP
S5_STATE = 64
SHIFT_W = 3 * D_RWKV + N_DIR * (LORA_W + LORA_A)
D_IN = SHIFT_W + D_RWKV + 2 * D_S5
EPS = 1e-6
LN_X_EPS = 64e-5
F32 = jnp.float32

kernel_name = 'hybrid_rwkv7_s5_dit_layer'


def rmsnorm(x, g):
    xf = x.astype(F32)
    return xf * lax.rsqrt(jnp.mean(xf * xf, axis=-1, keepdims=True) + EPS) * g


def modulation(cond, w_ada, b_ada):
    m = jax.nn.silu(cond.astype(F32)) @ w_ada + b_ada
    return jnp.split(m, 3, axis=-1)


def q_shift_grid(z, rows):
    b, l, ch = z.shape
    zg = z.reshape(b, rows, GRID_W, ch // 4, 4)
    zp = jnp.pad(zg, ((0, 0), (1, 1), (1, 1), (0, 0), (0, 0)))
    left = zp[:, 1:-1, :-2, :, 0]
    right = zp[:, 1:-1, 2:, :, 1]
    up = zp[:, :-2, 1:-1, :, 2]
    down = zp[:, 2:, 1:-1, :, 3]
    return jnp.stack([left, right, up, down], axis=-1).reshape(b, l, ch)


def shift_1d(z):
    b, l, ch = z.shape
    zp = jnp.pad(z.reshape(b, l, ch // 4, 4), ((0, 0), (1, 1), (0, 0), (0, 0)))
    prev, nxt = zp[:, :-2], zp[:, 2:]
    return jnp.stack([prev[..., 0], nxt[..., 1], prev[..., 2], nxt[..., 3]], axis=-1).reshape(b, l, ch)


def heads(t):
    return t.reshape(t.shape[:-1] + (N_HEADS, HEAD_DIM))


def rwkv7_step(S, inp):
    r, w, k, v, a, b = inp
    sa = jnp.einsum('dbhvk,dbhk->dbhv', S, a)
    S = S * w[..., None, :] + sa[..., :, None] * b[..., None, :] + v[..., :, None] * k[..., None, :]
    return S, jnp.einsum('dbhvk,dbhk->dbhv', S, r)


def rwkv7_branch(zs, g_r, p, s0, with_output):
    bsz, l, _ = zs.shape
    r, k, v, zw, za = jnp.split(zs, [D_RWKV, 2 * D_RWKV, 3 * D_RWKV, 3 * D_RWKV + N_DIR * LORA_W], axis=-1)
    zw = zw.reshape(bsz, l, N_DIR, LORA_W)
    za = za.reshape(bsz, l, N_DIR, LORA_A)
    w_log = -jax.nn.softplus(-(p['w0'] + jnp.einsum('bldr,drc->bldc', jnp.tanh(zw), p['w2']))) - 0.5
    decay = jnp.exp(-jnp.exp(w_log.astype(F32)))
    a = jax.nn.sigmoid(p['a0'] + jnp.einsum('bldr,drc->bldc', za, p['a2']))
    kk = heads((k * p['k_k']).astype(F32))
    kk = kk / jnp.maximum(jnp.sqrt(jnp.sum(kk * kk, axis=-1, keepdims=True)), 1e-12)
    kk = kk.reshape(bsz, l, D_RWKV)
    k_dir = k[:, :, None, :] * (1.0 + (a - 1.0) * p['k_a'])

    def dirs(t):
        t = jnp.stack([t[:, :, 0], jnp.flip(t[:, :, 1], axis=1)], axis=0)
        t = t.reshape(N_DIR, bsz, l, N_HEADS, HEAD_DIM).transpose(2, 0, 1, 3, 4)
        return t.astype(F32)

    def both(t):
        return dirs(jnp.stack([t, t], axis=2))

    kk_s = both(kk)
    s_fin, y = lax.scan(rwkv7_step, s0, (both(r), dirs(decay), dirs(k_dir), both(v), -kk_s, kk_s * dirs(a)))
    if not with_output:
        return None, s_fin
    y = y.transpose(1, 2, 0, 3, 4)
    y = y[0] + jnp.flip(y[1], axis=1)
    mean = jnp.mean(y, axis=-1, keepdims=True)
    var = jnp.mean(jnp.square(y - mean), axis=-1, keepdims=True)
    y = ((y - mean) * lax.rsqrt(var + LN_X_EPS)).reshape(bsz, l, D_RWKV) * p['lnx_g'] + p['lnx_b']
    rh = heads(r.astype(F32))
    kh = heads(jnp.mean(k_dir, axis=2).astype(F32))
    vh = heads(v.astype(F32))
    bonus = (jnp.sum(rh * kh * p['r_k'], axis=-1, keepdims=True) * vh).reshape(bsz, l, D_RWKV)
    return (y + bonus) * jax.nn.silu(g_r), s_fin


def s5_discretise(p):
    dt = jnp.exp(p['log_dt'].astype(F32))[..., None]
    lr = p['lam_re'].astype(F32)
    li = p['lam_im'].astype(F32)
    mag = jnp.exp(dt * lr)
    ar = mag * jnp.cos(dt * li)
    ai = mag * jnp.sin(dt * li)
    den = lr * lr + li * li
    fr = ((ar - 1.0) * lr + ai * li) / den
    fi = (ai * lr - (ar - 1.0) * li) / den
    b_re = p['b_re'].astype(F32)
    b_im = p['b_im'].astype(F32)
    bbr = fr[..., None] * b_re - fi[..., None] * b_im
    bbi = fr[..., None] * b_im + fi[..., None] * b_re
    return ar, ai, bbr, bbi


def s5_combine(e1, e2):
    a1r, a1i, b1r, b1i = e1
    a2r, a2i, b2r, b2i = e2
    return (a1r * a2r - a1i * a2i, a1r * a2i + a1i * a2r,
            a2r * b1r - a2i * b1i + b2r, a2r * b1i + a2i * b1r + b2i)


def s5_scan(ut, ar, ai, bbr, bbi, h0r, h0i):
    br = jnp.einsum('gpc,lbgc->lbgp', bbr, ut)
    bi = jnp.einsum('gpc,lbgc->lbgp', bbi, ut)
    br = br.at[0].add(ar * h0r - ai * h0i)
    bi = bi.at[0].add(ar * h0i + ai * h0r)
    l = ut.shape[0]
    a_re = jnp.broadcast_to(ar, (l, 1) + ar.shape)
    a_im = jnp.broadcast_to(ai, (l, 1) + ai.shape)
    _, _, hr, hi = lax.associative_scan(s5_combine, (a_re, a_im, br, bi), axis=0)
    return hr, hi


def s5_branch(u, g_s, p, h0_re, h0_im, with_output):
    bsz, l, _ = u.shape
    uf = u.astype(F32)
    ut = uf.reshape(bsz, l, N_GROUPS, S5_GROUP).transpose(1, 0, 2, 3)
    ar, ai, bbr, bbi = s5_discretise(p)
    y_sum = None
    fin_re = []
    fin_im = []
    for d in range(N_DIR):
        ud = ut if d == 0 else jnp.flip(ut, axis=0)
        hr, hi = s5_scan(ud, ar[d], ai[d], bbr[d], bbi[d], h0_re[d], h0_im[d])
        fin_re.append(hr[-1])
        fin_im.append(hi[-1])
        if with_output:
            yd = jnp.einsum('gcp,lbgp->lbgc', p['c_re'], hr) - jnp.einsum('gcp,lbgp->lbgc', p['c_im'], hi)
            yd = yd if d == 0 else jnp.flip(yd, axis=0)
            y_sum = yd if y_sum is None else y_sum + yd
    h_fin_re = jnp.stack(fin_re, axis=0)
    h_fin_im = jnp.stack(fin_im, axis=0)
    if not with_output:
        return None, h_fin_re, h_fin_im
    y = y_sum.transpose(1, 0, 2, 3).reshape(bsz, l, D_S5) + p['d'] * uf
    y = jax.nn.gelu(y)
    gl = y @ p['w_glu']
    y = gl[..., :D_S5] * jax.nn.sigmoid(gl[..., D_S5:])
    return y * jax.nn.silu(g_s), h_fin_re, h_fin_im


def mixer(h, shift_fn, p, s0, h0_re, h0_im, with_output):
    z = h @ p['w_in']
    zs, g_r, u, g_s = jnp.split(z, [SHIFT_W, SHIFT_W + D_RWKV, SHIFT_W + D_RWKV + D_S5], axis=-1)
    zs = zs + p['mu'] * (shift_fn(zs) - zs)
    y_r, s_fin = rwkv7_branch(zs, g_r, p, s0, with_output)
    y_s, h_fin_re, h_fin_im = s5_branch(u, g_s, p, h0_re, h0_im, with_output)
    if not with_output:
        return None, s_fin, h_fin_re, h_fin_im
    out = jnp.concatenate([y_r, y_s], axis=-1) @ p['w_out']
    return out, s_fin, h_fin_re, h_fin_im


def setup_inputs(seed: int = 0) -> dict:
    key = jax.random.key(seed)
    ks = jax.random.split(key, 32)

    def nrm(k, shape, scale):
        return jax.random.normal(k, shape, F32) * scale

    ramp = (jnp.arange(D_RWKV, dtype=F32) / (D_RWKV - 1)) ** 0.85
    return {
        'x': nrm(ks[0], (BATCH, SEQ, D_MODEL), 1.0),
        'c': nrm(ks[1], (BATCH, D_MODEL), 1.0),
        'ctx': nrm(ks[2], (BATCH, CTX_LEN, D_MODEL), 1.0),
        'c_ctx': nrm(ks[3], (D_MODEL,), 1.0),
        'norm_g': 1.0 + nrm(ks[4], (DEPTH, D_MODEL), 0.02),
        'w_ada': nrm(ks[5], (DEPTH, D_MODEL, 3 * D_MODEL), 0.5 * D_MODEL ** -0.5),
        'b_ada': nrm(ks[6], (DEPTH, 3 * D_MODEL), 0.02),
        'w_in': nrm(ks[7], (DEPTH, D_MODEL, D_IN), D_MODEL ** -0.5),
        'mu_shift': jax.random.uniform(ks[8], (DEPTH, SHIFT_W), F32, 0.2, 0.8),
        'rwkv_w0': -6.0 + 5.0 * ramp + nrm(ks[9], (DEPTH, N_DIR, D_RWKV), 0.1),
        'rwkv_w2': nrm(ks[10], (DEPTH, N_DIR, LORA_W, D_RWKV), 0.5 * LORA_W ** -0.5),
        'rwkv_a0': nrm(ks[11], (DEPTH, N_DIR, D_RWKV), 0.1),
        'rwkv_a2': nrm(ks[12], (DEPTH, N_DIR, LORA_A, D_RWKV), 0.5 * LORA_A ** -0.5),
        'rwkv_k_k': 0.85 + nrm(ks[13], (DEPTH, D_RWKV), 0.02),
        'rwkv_k_a': 1.0 + nrm(ks[14], (DEPTH, D_RWKV), 0.02),
        'rwkv_r_k': nrm(ks[15], (DEPTH, N_HEADS, HEAD_DIM), 0.1),
        'lnx_g': 1.0 + nrm(ks[16], (DEPTH, D_RWKV), 0.02),
        'lnx_b': nrm(ks[17], (DEPTH, D_RWKV), 0.02),
        's5_lam_re': -0.5 + nrm(ks[18], (DEPTH, N_DIR, N_GROUPS, S5_STATE), 0.01),
        's5_lam_im': math.pi * jnp.arange(S5_STATE, dtype=F32) + nrm(ks[19], (DEPTH, N_DIR, N_GROUPS, S5_STATE), 0.01),
        's5_log_dt': jax.random.uniform(ks[20], (DEPTH, N_DIR, N_GROUPS), F32, math.log(0.001), math.log(0.1)),
        's5_b_re': nrm(ks[21], (DEPTH, N_GROUPS, S5_STATE, S5_GROUP), (2 * S5_GROUP) ** -0.5),
        's5_b_im': nrm(ks[22], (DEPTH, N_GROUPS, S5_STATE, S5_GROUP), (2 * S5_GROUP) ** -0.5),
        's5_c_re': nrm(ks[23], (DEPTH, N_GROUPS, S5_GROUP, S5_STATE), (2 * S5_STATE) ** -0.5),
        's5_c_im': nrm(ks[24], (DEPTH, N_GROUPS, S5_GROUP, S5_STATE), (2 * S5_STATE) ** -0.5),
        's5_d': nrm(ks[25], (DEPTH, D_S5), 0.5),
        's5_w_glu': nrm(ks[26], (DEPTH, D_S5, 2 * D_S5), D_S5 ** -0.5),
        'w_out': nrm(ks[27], (DEPTH, D_MIX, D_MODEL), D_MIX ** -0.5),
        'final_g': 1.0 + nrm(ks[28], (D_MODEL,), 0.02),
    }


def reference(x, c, ctx, c_ctx, norm_g, w_ada, b_ada, w_in, mu_shift, rwkv_w0, rwkv_w2, rwkv_a0,
              rwkv_a2, rwkv_k_k, rwkv_k_a, rwkv_r_k, lnx_g, lnx_b, s5_lam_re, s5_lam_im, s5_log_dt,
              s5_b_re, s5_b_im, s5_c_re, s5_c_im, s5_d, s5_w_glu, w_out, final_g):
    out_dtype = x.dtype
    bsz = x.shape[0]
    rows = x.shape[1] // GRID_W
    latent_shift = functools.partial(q_shift_grid, rows=rows)
    for i in range(DEPTH):
        p = {'w_in': w_in[i], 'mu': mu_shift[i], 'w0': rwkv_w0[i], 'w2': rwkv_w2[i],
             'a0': rwkv_a0[i], 'a2': rwkv_a2[i], 'k_k': rwkv_k_k[i], 'k_a': rwkv_k_a[i],
             'r_k': rwkv_r_k[i], 'lnx_g': lnx_g[i], 'lnx_b': lnx_b[i],
             'lam_re': s5_lam_re[i], 'lam_im': s5_lam_im[i], 'log_dt': s5_log_dt[i],
             'b_re': s5_b_re[i], 'b_im': s5_b_im[i], 'c_re': s5_c_re[i], 'c_im': s5_c_im[i],
             'd': s5_d[i], 'w_glu': s5_w_glu[i], 'w_out': w_out[i]}
        last = i == DEPTH - 1
        shift, scale, gate = (t[:, None, :] for t in modulation(c, w_ada[i], b_ada[i]))
        cshift, cscale, cgate = modulation(c_ctx, w_ada[i], b_ada[i])
        hc = rmsnorm(ctx, norm_g[i]) * (1.0 + cscale) + cshift
        s0 = jnp.zeros((N_DIR, bsz, N_HEADS, HEAD_DIM, HEAD_DIM), F32)
        h0 = jnp.zeros((N_DIR, bsz, N_GROUPS, S5_STATE), F32)
        out_c, s_ctx, h_ctx_re, h_ctx_im = mixer(hc, shift_1d, p, s0, h0, h0, not last)
        hx = rmsnorm(x, norm_g[i]) * (1.0 + scale) + shift
        out_x, _, _, _ = mixer(hx, latent_shift, p, s_ctx, h_ctx_re, h_ctx_im, True)
        x = x + gate * out_x
        if not last:
            ctx = ctx + cgate * out_c
    return rmsnorm(x, final_g).astype(out_dtype)
```

```cpp
#include <hip/hip_runtime.h>
#include <stdint.h>

constexpr int B_ = 8, L_ = 4096, LC_ = 256, D_ = 1024, DIN_ = 3328, SW_ = 1792, DR_ = 512, DS_ = 512;
constexpr int NH_ = 8, HD_ = 64, NG_ = 32, NP_ = 64, TS5 = 16;
constexpr int SEQA = LC_ + L_;
constexpr int NTOK = B_ * SEQA;
constexpr int NCTX = B_ * LC_;
constexpr int NLAT = B_ * L_;
constexpr int NCH_ALL = SEQA / TS5;
constexpr int NCH_CTX = LC_ / TS5;
constexpr int OPS_REC = 9 * 64;
enum { F_R = 0, F_V = 1, F_KK = 2, F_OMW0 = 3, F_B0 = 4, F_KD0 = 5, F_OMW1 = 6, F_B1 = 7, F_KD1 = 8 };

typedef unsigned short bf16_t;
using bf16x8 = __attribute__((ext_vector_type(8))) short;
using f32x4 = __attribute__((ext_vector_type(4))) float;
typedef __bf16 bf16x2_t __attribute__((ext_vector_type(2)));
typedef float f32x2_t __attribute__((ext_vector_type(2)));

constexpr size_t al256(size_t x) { return (x + 255) & ~(size_t)255; }
constexpr size_t WS_GR = 0;
constexpr size_t WS_U = WS_GR + al256((size_t)NTOK * 512 * 2);
constexpr size_t WS_GS = WS_U + al256((size_t)NTOK * 512 * 2);
constexpr size_t WS_OPS = WS_GS + al256((size_t)NTOK * 512 * 2);
constexpr size_t WS_Y = WS_OPS + al256((size_t)B_ * NH_ * SEQA * OPS_REC * 2);
constexpr size_t WS_WINT = WS_Y + al256((size_t)2 * NLAT * 512 * 2);
constexpr size_t WS_WGLUT = WS_WINT + al256((size_t)DIN_ * D_ * 2);
constexpr size_t WS_WOUTT = WS_WGLUT + al256((size_t)1024 * 512 * 2);
constexpr size_t WS_W2T = WS_WOUTT + al256((size_t)1024 * 1024 * 2);
constexpr size_t WS_A2T = WS_W2T + al256((size_t)2 * 512 * 64 * 2);
constexpr size_t WS_G1 = WS_A2T + al256((size_t)2 * 512 * 64 * 2);
constexpr size_t WS_G2 = WS_G1 + al256((size_t)NG_ * 256 * 256 * 2);
constexpr size_t WS_AP = WS_G2 + al256((size_t)NG_ * 256 * 512 * 2);
constexpr size_t WS_BBAR = WS_AP + al256((size_t)2 * NG_ * NP_ * 17 * 8);
constexpr size_t WS_KT = WS_BBAR + al256((size_t)2 * NG_ * NP_ * 16 * 8);
constexpr size_t WS_CTL = WS_KT + al256((size_t)2 * NG_ * 16 * 256 * 4);
constexpr size_t WS_MOD = WS_CTL + 16384;
constexpr size_t WS_ROWSS = WS_MOD + al256((size_t)9 * 3072 * 4);
constexpr size_t WS_ZERO_END = WS_ROWSS + al256((size_t)NLAT * 4);
constexpr size_t WS_GM = WS_ZERO_END;
constexpr size_t WS_SH = WS_GM + al256((size_t)9 * 1024 * 4);
constexpr size_t WS_RS = WS_SH + al256((size_t)9 * 1024 * 4);
constexpr size_t WS_COEF = WS_RS + al256((size_t)NTOK * 4);
constexpr size_t WS_END = WS_COEF + al256((size_t)NLAT * 8 * 4);
constexpr size_t DO_ZS = 0;
constexpr size_t DO_E = 0;
constexpr size_t DO_YS5 = al256((size_t)B_ * NCH_ALL * NG_ * 256 * 4);

struct Params {
  const float *x, *c, *ctx, *c_ctx, *norm_g, *w_ada, *b_ada, *w_in, *mu, *w0, *w2, *a0, *a2, *k_k, *k_a, *r_k, *lnx_g, *lnx_b;
  const float *lam_re, *lam_im, *log_dt, *b_re, *b_im, *c_re, *c_im, *s5_d, *w_glu, *w_out, *final_g;
  float* out;
  unsigned char* ws;
};

__device__ __forceinline__ float bf2f(bf16_t h) { return __uint_as_float(((unsigned)h) << 16); }
__device__ __forceinline__ unsigned pack2(float a, float b) {
  f32x2_t v = {a, b};
  bf16x2_t r = __builtin_convertvector(v, bf16x2_t);
  return __builtin_bit_cast(unsigned, r);
}
__device__ __forceinline__ float lo2f(unsigned u) { return __uint_as_float(u << 16); }
__device__ __forceinline__ float hi2f(unsigned u) { return __uint_as_float(u & 0xffff0000u); }
template <int CTRL>
__device__ __forceinline__ float dpp_mov(float v) {
  return __builtin_bit_cast(float, __builtin_amdgcn_update_dpp(0, __builtin_bit_cast(int, v), CTRL, 0xF, 0xF, true));
}
__device__ __forceinline__ float allreduce16(float v) {
  v += dpp_mov<0xB1>(v);
  v += dpp_mov<0x4E>(v);
  v += dpp_mov<0x141>(v);
  v += dpp_mov<0x140>(v);
  return v;
}
__device__ __forceinline__ int opaque_tid() {
  int t = threadIdx.x;
  asm volatile("" : "+v"(t));
  return t;
}
__device__ __forceinline__ float sigmoidf_(float x) { return 1.f / (1.f + __expf(-x)); }
__device__ __forceinline__ float siluf_(float x) { return x / (1.f + __expf(-x)); }
__device__ __forceinline__ float gelu_tanh(float y) {
  float t = 0.7978845608028654f * (y + 0.044715f * y * y * y);
  float e = __expf(2.f * t);
  float th = 1.f - 2.f / (e + 1.f);
  return 0.5f * y * (1.f + th);
}
__device__ __forceinline__ int tokrow(int b, int s) {
  return s < LC_ ? b * LC_ + s : NCTX + b * L_ + (s - LC_);
}

struct GemmSmem {
  bf16_t A[2][128][40];
  bf16_t B[2][128][40];
};
template <class AL, class BL, class EP>
__device__ __forceinline__ void gemm_tile(const AL& al, const BL& bl, EP& ep, int K, unsigned char* smem_raw) {
  GemmSmem& sm = *reinterpret_cast<GemmSmem*>(smem_raw);
  const int tid = opaque_tid(), lane = tid & 63, w = tid >> 6;
  const int wr = w >> 1, wc = w & 1;
  f32x4 acc[4][4];
#pragma unroll
  for (int i = 0; i < 4; ++i)
#pragma unroll
    for (int j = 0; j < 4; ++j) acc[i][j] = (f32x4){0.f, 0.f, 0.f, 0.f};
  const int r0 = tid >> 2, kg = (tid & 3) * 8;
  uint4 ra[2], rb[2];
  const int nk = K >> 5;
#pragma unroll
  for (int i = 0; i < 2; ++i) {
    ra[i] = al.load(r0 + i * 64, kg);
    rb[i] = bl.load(r0 + i * 64, kg);
  }
#pragma unroll
  for (int i = 0; i < 2; ++i) {
    *reinterpret_cast<uint4*>(&sm.A[0][r0 + i * 64][kg]) = ra[i];
    *reinterpret_cast<uint4*>(&sm.B[0][r0 + i * 64][kg]) = rb[i];
  }
  __syncthreads();
  for (int kt = 0; kt < nk; ++kt) {
    const int cur = kt & 1;
    if (kt + 1 < nk) {
#pragma unroll
      for (int i = 0; i < 2; ++i) {
        ra[i] = al.load(r0 + i * 64, (kt + 1) * 32 + kg);
        rb[i] = bl.load(r0 + i * 64, (kt + 1) * 32 + kg);
      }
    }
    bf16x8 af[4], bfr[4];
#pragma unroll
    for (int i = 0; i < 4; ++i) af[i] = *reinterpret_cast<const bf16x8*>(&sm.A[cur][wr * 64 + i * 16 + (lane & 15)][(lane >> 4) * 8]);
#pragma unroll
    for (int j = 0; j < 4; ++j) bfr[j] = *reinterpret_cast<const bf16x8*>(&sm.B[cur][wc * 64 + j * 16 + (lane & 15)][(lane >> 4) * 8]);
#pragma unroll
    for (int i = 0; i < 4; ++i)
#pragma unroll
      for (int j = 0; j < 4; ++j) acc[i][j] = __builtin_amdgcn_mfma_f32_16x16x32_bf16(bfr[j], af[i], acc[i][j], 0, 0, 0);
    if (kt + 1 < nk) {
#pragma unroll
      for (int i = 0; i < 2; ++i) {
        *reinterpret_cast<uint4*>(&sm.A[cur ^ 1][r0 + i * 64][kg]) = ra[i];
        *reinterpret_cast<uint4*>(&sm.B[cur ^ 1][r0 + i * 64][kg]) = rb[i];
      }
    }
    __syncthreads();
  }
  ep(acc, wr, wc, lane);
}

__device__ void ph_mod(const Params& p, int bid, int nb) {
  float* MOD = (float*)(p.ws + WS_MOD);
  const int tid = opaque_tid();
  for (int it = bid; it < 12 * 16; it += nb) {
    const int nblk = it % 12, kc = it / 12;
    const int n = nblk * 256 + tid;
    float acc[9];
#pragma unroll
    for (int j = 0; j < 9; ++j) acc[j] = 0.f;
    for (int k = kc * 64; k < kc * 64 + 64; ++k) {
      const float wv = p.w_ada[(size_t)k * 3072 + n];
#pragma unroll
      for (int j = 0; j < 9; ++j) {
        const float cv = (j < 8) ? p.c[j * 1024 + k] : p.c_ctx[k];
        acc[j] += siluf_(cv) * wv;
      }
    }
    const float bias = (kc == 0) ? p.b_ada[n] : 0.f;
#pragma unroll
    for (int j = 0; j < 9; ++j) atomicAdd(&MOD[j * 3072 + n], acc[j] + bias);
  }
}

__device__ void ph_gmsh(const Params& p, int bid, int nb) {
  const float* MOD = (const float*)(p.ws + WS_MOD);
  float* GM = (float*)(p.ws + WS_GM);
  float* SH = (float*)(p.ws + WS_SH);
  for (int i = bid * 256 + opaque_tid(); i < 9 * 1024; i += nb * 256) {
    const int j = i >> 10, k = i & 1023;
    GM[i] = p.norm_g[k] * (1.f + MOD[j * 3072 + 1024 + k]);
    SH[i] = MOD[j * 3072 + k];
  }
}

__device__ __forceinline__ void transpose_item(const float* __restrict__ src, int K, int N, bf16_t* __restrict__ dst, int item, float* tile  ) {
  const int nk = K / 32;
  const int kt = item % nk, nt = item / nk;
  const int tid = opaque_tid();
  const int tx = tid & 31, ty = tid >> 5;
#pragma unroll
  for (int i = 0; i < 4; ++i) {
    const int kk = ty + i * 8;
    tile[kk * 33 + tx] = src[(size_t)(kt * 32 + kk) * N + nt * 32 + tx];
  }
  __syncthreads();
#pragma unroll
  for (int i = 0; i < 4; ++i) {
    const int nn = ty + i * 8;
    const float v = tile[tx * 33 + nn];
    f32x2_t vv = {v, 0.f};
    bf16x2_t r = __builtin_convertvector(vv, bf16x2_t);
    dst[(size_t)(nt * 32 + nn) * K + kt * 32 + tx] = (bf16_t)(__builtin_bit_cast(unsigned, r) & 0xffff);
  }
  __syncthreads();
}
__device__ void ph_transpose(const Params& p, int bid, int nb, unsigned char* smem) {
  float* tile = (float*)smem;
  constexpr int I_IN = (D_ / 32) * (DIN_ / 32), I_GLU = (512 / 32) * (1024 / 32), I_OUT = 32 * 32, I_L = (64 / 32) * (512 / 32);
  constexpr int TOT = I_IN + I_GLU + I_OUT + 4 * I_L;
  for (int it = bid; it < TOT; it += nb) {
    int r = it;
    if (r < I_IN) { transpose_item(p.w_in, D_, DIN_, (bf16_t*)(p.ws + WS_WINT), r, tile); continue; }
    r -= I_IN;
    if (r < I_GLU) { transpose_item(p.w_glu, 512, 1024, (bf16_t*)(p.ws + WS_WGLUT), r, tile); continue; }
    r -= I_GLU;
    if (r < I_OUT) { transpose_item(p.w_out, 1024, 1024, (bf16_t*)(p.ws + WS_WOUTT), r, tile); continue; }
    r -= I_OUT;
    const int which = r / I_L, rr = r % I_L;
    const float* src = (which < 2 ? p.w2 : p.a2) + (size_t)(which & 1) * 64 * 512;
    bf16_t* dst = (bf16_t*)(p.ws + (which < 2 ? WS_W2T : WS_A2T)) + (size_t)(which & 1) * 512 * 64;
    transpose_item(src, 64, 512, dst, rr, tile);
  }
}

__device__ void ph_rs(const Params& p, int bid, int nb) {
  float* RS = (float*)(p.ws + WS_RS);
  const int tid = opaque_tid();
  const int lane = tid & 63, w = tid >> 6;
  for (int m = bid * 4 + w; m < NTOK; m += nb * 4) {
    const float* row = (m < NCTX) ? p.ctx + (size_t)m * D_ : p.x + (size_t)(m - NCTX) * D_;
    float s = 0.f;
#pragma unroll
    for (int i = 0; i < 4; ++i) {
      const float4 v = *reinterpret_cast<const float4*>(row + i * 256 + lane * 4);
      s += v.x * v.x + v.y * v.y + v.z * v.z + v.w * v.w;
    }
#pragma unroll
    for (int o = 32; o >= 1; o >>= 1) s += __shfl_xor(s, o);
    if (lane == 0) RS[m] = rsqrtf(s * (1.f / D_) + 1e-6f);
  }
}

__device__ void ph_s5_ap(const Params& p, int bid, int nb) {
  float2* AP = (float2*)(p.ws + WS_AP);
  float2* BB = (float2*)(p.ws + WS_BBAR);
  for (int i = bid * 256 + opaque_tid(); i < 2 * NG_ * NP_; i += nb * 256) {
    const int pp = i & 63, g = (i >> 6) & 31, d = i >> 11;
    const double dt = exp((double)p.log_dt[d * NG_ + g]);
    const double lr = (double)p.lam_re[(d * NG_ + g) * NP_ + pp], li = (double)p.lam_im[(d * NG_ + g) * NP_ + pp];
    for (int n = 0; n <= 16; ++n) {
      const double mag = exp(n * dt * lr);
      AP[(size_t)i * 17 + n] = make_float2((float)(mag * cos(n * dt * li)), (float)(mag * sin(n * dt * li)));
    }
    const double mag = exp(dt * lr), ar = mag * cos(dt * li), ai = mag * sin(dt * li);
    const double den = lr * lr + li * li;
    const double fr = ((ar - 1.0) * lr + ai * li) / den, fi = (ai * lr - (ar - 1.0) * li) / den;
    for (int c = 0; c < 16; ++c) {
      const double br = (double)p.b_re[(g * NP_ + pp) * 16 + c], bi = (double)p.b_im[(g * NP_ + pp) * 16 + c];
      BB[(size_t)i * 16 + c] = make_float2((float)(fr * br - fi * bi), (float)(fr * bi + fi * br));
    }
  }
}
__device__ void ph_s5_kt(const Params& p, int bid, int nb) {
  const float2* AP = (const float2*)(p.ws + WS_AP);
  const float2* BB = (const float2*)(p.ws + WS_BBAR);
  float* KT = (float*)(p.ws + WS_KT);
  for (int i = bid * 256 + opaque_tid(); i < 2 * NG_ * 16 * 256; i += nb * 256) {
    const int c = i & 15, cp = (i >> 4) & 15, tau = (i >> 8) & 15, g = (i >> 12) & 31, d = i >> 17;
    float acc = 0.f;
    for (int pp = 0; pp < NP_; ++pp) {
      const float cr = p.c_re[(g * 16 + cp) * NP_ + pp], ci = p.c_im[(g * 16 + cp) * NP_ + pp];
      const float2 a = AP[(size_t)((d * NG_ + g) * NP_ + pp) * 17 + tau];
      const float2 bb = BB[(size_t)((d * NG_ + g) * NP_ + pp) * 16 + c];
      const float qr = cr * a.x - ci * a.y, qi = cr * a.y + ci * a.x;
      acc += qr * bb.x - qi * bb.y;
    }
    KT[i] = acc;
  }
}
__device__ void ph_s5_g(const Params& p, int bid, int nb) {
  const float2* AP = (const float2*)(p.ws + WS_AP);
  const float2* BB = (const float2*)(p.ws + WS_BBAR);
  const float* KT = (const float*)(p.ws + WS_KT);
  bf16_t* G1 = (bf16_t*)(p.ws + WS_G1);
  bf16_t* G2 = (bf16_t*)(p.ws + WS_G2);
  const int n1 = NG_ * 256 * 256, n2 = NG_ * 256 * 512;
  for (int i = bid * 256 + opaque_tid(); i < n1 + n2; i += nb * 256) {
    float val;
    if (i < n1) {
      const int k = i & 255, n = (i >> 8) & 255, g = i >> 16;
      const int s = k >> 4, c = k & 15, d = n >> 7, ri = (n >> 6) & 1, pp = n & 63;
      const int pw = d == 0 ? 15 - s : s;
      const float2 a = AP[(size_t)((d * NG_ + g) * NP_ + pp) * 17 + pw];
      const float2 bb = BB[(size_t)((d * NG_ + g) * NP_ + pp) * 16 + c];
      val = ri == 0 ? a.x * bb.x - a.y * bb.y : a.x * bb.y + a.y * bb.x;
      G1[i] = (bf16_t)(pack2(val, 0.f) & 0xffff);
    } else {
      const int i2 = i - n1;
      const int k = i2 & 511, n = (i2 >> 9) & 255, g = i2 >> 17;
      const int sp = n >> 4, cp = n & 15;
      if (k < 256) {
        const int s = k >> 4, c = k & 15;
        val = 0.f;
        if (s <= sp) val += KT[(((0 * NG_ + g) * 16 + (sp - s)) * 16 + cp) * 16 + c];
        if (s >= sp) val += KT[(((1 * NG_ + g) * 16 + (s - sp)) * 16 + cp) * 16 + c];
      } else {
        const int kk = k - 256, d = kk >> 7, ri = (kk >> 6) & 1, pp = kk & 63;
        const int pw = d == 0 ? sp + 1 : 16 - sp;
        const float2 a = AP[(size_t)((d * NG_ + g) * NP_ + pp) * 17 + pw];
        const float cr = p.c_re[(g * 16 + cp) * NP_ + pp], ci = p.c_im[(g * 16 + cp) * NP_ + pp];
        const float qr = cr * a.x - ci * a.y, qi = cr * a.y + ci * a.x;
        val = ri == 0 ? qr : -qi;
      }
      G2[i2] = (bf16_t)(pack2(val, 0.f) & 0xffff);
    }
  }
}

struct AL_X {
  const float* base;
  const float* rs;
  const float* gm;
  const float* sh;
  __device__ __forceinline__ uint4 load(int row, int k) const {
    const float4 a0 = *reinterpret_cast<const float4*>(base + (size_t)row * D_ + k);
    const float4 a1 = *reinterpret_cast<const float4*>(base + (size_t)row * D_ + k + 4);
    const float4 g0 = *reinterpret_cast<const float4*>(gm + k), g1 = *reinterpret_cast<const float4*>(gm + k + 4);
    const float4 s0 = *reinterpret_cast<const float4*>(sh + k), s1 = *reinterpret_cast<const float4*>(sh + k + 4);
    const float r = rs[row];
    uint4 o;
    o.x = pack2(a0.x * r * g0.x + s0.x, a0.y * r * g0.y + s0.y);
    o.y = pack2(a0.z * r * g0.z + s0.z, a0.w * r * g0.w + s0.w);
    o.z = pack2(a1.x * r * g1.x + s1.x, a1.y * r * g1.y + s1.y);
    o.w = pack2(a1.z * r * g1.z + s1.z, a1.w * r * g1.w + s1.w);
    return o;
  }
};
struct BL_Rows {
  const bf16_t* base;
  int ld;
  __device__ __forceinline__ uint4 load(int col, int k) const { return *reinterpret_cast<const uint4*>(base + (size_t)col * ld + k); }
};
struct EP_Z {
  bf16_t* dst;
  int ld;
  __device__ __forceinline__ void operator()(f32x4 (&acc)[4][4], int wr, int wc, int lane) {
#pragma unroll
    for (int i = 0; i < 4; ++i)
#pragma unroll
      for (int j = 0; j < 4; ++j) {
        const int row = wr * 64 + i * 16 + (lane & 15), col = wc * 64 + j * 16 + 4 * (lane >> 4);
        uint2 o;
        o.x = pack2(acc[i][j][0], acc[i][j][1]);
        o.y = pack2(acc[i][j][2], acc[i][j][3]);
        *reinterpret_cast<uint2*>(dst + (size_t)row * ld + col) = o;
      }
  }
};
__device__ void ph_gemm1(const Params& p, int bid, int nb, unsigned char* smem) {
  const float* RS = (const float*)(p.ws + WS_RS);
  const float* GM = (const float*)(p.ws + WS_GM);
  const float* SH = (const float*)(p.ws + WS_SH);
  const bf16_t* WT = (const bf16_t*)(p.ws + WS_WINT);
  bf16_t* ZS = (bf16_t*)((unsigned char*)p.out + DO_ZS);
  constexpr int NT = DIN_ / 128;
  for (int t = bid; t < (NTOK / 128) * NT; t += nb) {
    const int mt = t / NT, nt = t % NT;
    const int m0 = mt * 128, n0 = nt * 128;
    const int j = (m0 < NCTX) ? 8 : (m0 - NCTX) / L_;
    AL_X al{(m0 < NCTX) ? p.ctx + (size_t)m0 * D_ : p.x + (size_t)(m0 - NCTX) * D_, RS + m0, GM + j * 1024, SH + j * 1024};
    BL_Rows bl{WT + (size_t)n0 * D_, D_};
    EP_Z ep;
    if (n0 < SW_) { ep.dst = ZS + (size_t)m0 * SW_ + n0; ep.ld = SW_; }
    else if (n0 < SW_ + 512) { ep.dst = (bf16_t*)(p.ws + WS_GR) + (size_t)m0 * 512 + (n0 - SW_); ep.ld = 512; }
    else if (n0 < SW_ + 1024) { ep.dst = (bf16_t*)(p.ws + WS_U) + (size_t)m0 * 512 + (n0 - SW_ - 512); ep.ld = 512; }
    else { ep.dst = (bf16_t*)(p.ws + WS_GS) + (size_t)m0 * 512 + (n0 - SW_ - 1024); ep.ld = 512; }
    gemm_tile(al, bl, ep, D_, smem);
  }
}

struct PrepSmem {
  bf16_t lwa[4][16][72];
  float rkv[3][16][64];
  float lo[4][16][65];
};
__device__ void ph_prep(const Params& p, int bid, int nb, unsigned char* smem) {
  PrepSmem& sm = *reinterpret_cast<PrepSmem*>(smem);
  const bf16_t* ZS = (const bf16_t*)((const unsigned char*)p.out + DO_ZS);
  const bf16_t* W2T = (const bf16_t*)(p.ws + WS_W2T);
  const bf16_t* A2T = (const bf16_t*)(p.ws + WS_A2T);
  bf16_t* OPS = (bf16_t*)(p.ws + WS_OPS);
  float* COEF = (float*)(p.ws + WS_COEF);
  const int tid = opaque_tid(), lane = tid & 63, w = tid >> 6;
  const int tok = tid >> 4, cg = tid & 15;
  for (int it = bid; it < (NTOK / 16) * NH_; it += nb) {
    const int h = it & 7, tg = it >> 3;
    int b, t0, isctx;
    if (tg < NCTX / 16) { isctx = 1; b = tg / 16; t0 = (tg % 16) * 16; }
    else { isctx = 0; const int lg = tg - NCTX / 16; b = lg / 256; t0 = (lg % 256) * 16; }
    const int t = t0 + tok;
    const int m = isctx ? b * LC_ + t : NCTX + b * L_ + t;
    int nbr[4];
    if (isctx) {
      nbr[0] = nbr[2] = (t > 0) ? m - 1 : -1;
      nbr[1] = nbr[3] = (t < LC_ - 1) ? m + 1 : -1;
    } else {
      nbr[0] = ((t & 63) > 0) ? m - 1 : -1;
      nbr[1] = ((t & 63) < 63) ? m + 1 : -1;
      nbr[2] = (t >= 64) ? m - 64 : -1;
      nbr[3] = (t < L_ - 64) ? m + 64 : -1;
    }
    {
      const int cbase = 3 * DR_ + cg * 16;
      const bf16_t* own = ZS + (size_t)m * SW_ + cbase;
      uint4 o0 = *reinterpret_cast<const uint4*>(own), o1 = *reinterpret_cast<const uint4*>(own + 8);
      unsigned ow[8] = {o0.x, o0.y, o0.z, o0.w, o1.x, o1.y, o1.z, o1.w};
      float val[16];
#pragma unroll
      for (int i = 0; i < 8; ++i) { val[2 * i] = lo2f(ow[i]); val[2 * i + 1] = hi2f(ow[i]); }
      float nv[16];
#pragma unroll
      for (int i = 0; i < 16; ++i) nv[i] = 0.f;
#pragma unroll
      for (int s = 0; s < 4; ++s) {
        if (nbr[s] >= 0) {
          const bf16_t* np_ = ZS + (size_t)nbr[s] * SW_ + cbase;
          uint4 n0 = *reinterpret_cast<const uint4*>(np_), n1 = *reinterpret_cast<const uint4*>(np_ + 8);
          unsigned nw[8] = {n0.x, n0.y, n0.z, n0.w, n1.x, n1.y, n1.z, n1.w};
#pragma unroll
          for (int q = 0; q < 4; ++q) {
            const int col = q * 4 + s;
            nv[col] = (col & 1) ? hi2f(nw[col >> 1]) : lo2f(nw[col >> 1]);
          }
        }
      }
      const int which = cg >> 2;
      const int idx = (which & 1) * 2 + (which >> 1);
      const int cb = (cg & 3) * 16;
      float res[16];
#pragma unroll
      for (int i = 0; i < 16; ++i) {
        const float mu = p.mu[cbase + i];
        float v = val[i] + mu * (nv[i] - val[i]);
        if (which < 2) v = tanhf(v);
        res[i] = v;
      }
#pragma unroll
      for (int i = 0; i < 8; ++i) *reinterpret_cast<unsigned*>(&sm.lwa[idx][tok][cb + 2 * i]) = pack2(res[2 * i], res[2 * i + 1]);
    }
#pragma unroll
    for (int f = 0; f < 3; ++f) {
      const int cbase = f * DR_ + h * 64 + cg * 4;
      const uint2 o = *reinterpret_cast<const uint2*>(ZS + (size_t)m * SW_ + cbase);
      float val[4] = {lo2f(o.x), hi2f(o.x), lo2f(o.y), hi2f(o.y)};
      float nv[4] = {0.f, 0.f, 0.f, 0.f};
#pragma unroll
      for (int s = 0; s < 4; ++s) {
        if (nbr[s] >= 0) {
          const uint2 n = *reinterpret_cast<const uint2*>(ZS + (size_t)nbr[s] * SW_ + cbase);
          nv[s] = (s == 0) ? lo2f(n.x) : (s == 1) ? hi2f(n.x) : (s == 2) ? lo2f(n.y) : hi2f(n.y);
        }
      }
#pragma unroll
      for (int i = 0; i < 4; ++i) {
        const float mu = p.mu[cbase + i];
        sm.rkv[f][tok][cg * 4 + i] = val[i] + mu * (nv[i] - val[i]);
      }
    }
    __syncthreads();
    {
      const int d = w >> 1, type = w & 1;
      const bf16_t* W = (type == 0 ? W2T : A2T) + (size_t)d * 512 * 64 + (size_t)(h * 64) * 64;
      f32x4 acc[4];
#pragma unroll
      for (int jt = 0; jt < 4; ++jt) acc[jt] = (f32x4){0.f, 0.f, 0.f, 0.f};
#pragma unroll
      for (int ks = 0; ks < 2; ++ks) {
        const bf16x8 af = *reinterpret_cast<const bf16x8*>(&sm.lwa[w][lane & 15][ks * 32 + (lane >> 4) * 8]);
#pragma unroll
        for (int jt = 0; jt < 4; ++jt) {
          const bf16x8 wf = *reinterpret_cast<const bf16x8*>(W + (size_t)(jt * 16 + (lane & 15)) * 64 + ks * 32 + (lane >> 4) * 8);
          acc[jt] = __builtin_amdgcn_mfma_f32_16x16x32_bf16(wf, af, acc[jt], 0, 0, 0);
        }
      }
#pragma unroll
      for (int jt = 0; jt < 4; ++jt)
#pragma unroll
        for (int r = 0; r < 4; ++r) sm.lo[w][lane & 15][jt * 16 + 4 * (lane >> 4) + r] = acc[jt][r];
    }
    __syncthreads();
    {
      float r_[4], k_[4], v_[4], kk[4];
      float ss = 0.f;
#pragma unroll
      for (int i = 0; i < 4; ++i) {
        const int c = cg * 4 + i, ch = h * 64 + c;
        r_[i] = sm.rkv[0][tok][c]; k_[i] = sm.rkv[1][tok][c]; v_[i] = sm.rkv[2][tok][c];
        kk[i] = k_[i] * p.k_k[ch];
        ss += kk[i] * kk[i];
      }
      ss = allreduce16(ss);
      const float inv = 1.f / fmaxf(sqrtf(ss), 1e-12f);
      float omw[2][4], bb[2][4], kd[2][4];
      float cf = 0.f;
#pragma unroll
      for (int i = 0; i < 4; ++i) {
        const int c = cg * 4 + i, ch = h * 64 + c;
        kk[i] *= inv;
#pragma unroll
        for (int d = 0; d < 2; ++d) {
          const float wl = p.w0[d * DR_ + ch] + sm.lo[d * 2 + 0][tok][c];
          const float sg = 1.f / (1.f + expf(-wl));
          omw[d][i] = -expm1f(-0.6065306597126334f * sg);
          const float al = 1.f / (1.f + expf(-(p.a0[d * DR_ + ch] + sm.lo[d * 2 + 1][tok][c])));
          kd[d][i] = k_[i] * (1.f + (al - 1.f) * p.k_a[ch]);
          bb[d][i] = kk[i] * al;
        }
        cf += r_[i] * 0.5f * (kd[0][i] + kd[1][i]) * p.r_k[ch];
      }
      cf = allreduce16(cf);
      const int s = isctx ? t : LC_ + t;
      bf16_t* rec = OPS + ((size_t)(b * NH_ + h) * SEQA + s) * OPS_REC + cg * 4;
      auto st4 = [&](int f, const float* v4) {
        uint2 o;
        o.x = pack2(v4[0], v4[1]);
        o.y = pack2(v4[2], v4[3]);
        *reinterpret_cast<uint2*>(rec + f * 64) = o;
      };
      st4(F_R, r_); st4(F_V, v_); st4(F_KK, kk);
      st4(F_OMW0, omw[0]); st4(F_B0, bb[0]); st4(F_KD0, kd[0]);
      st4(F_OMW1, omw[1]); st4(F_B1, bb[1]); st4(F_KD1, kd[1]);
      if (!isctx && cg == 0) COEF[((size_t)b * L_ + t) * NH_ + h] = cf;
    }
    __syncthreads();
  }
}

constexpr int SC_T = 16;
constexpr int SC_STRIDE = 352;
struct ScanSmem {
  float ops[2][SC_T][SC_STRIDE];
  float ybuf[SC_T][32];
};
__device__ void ph_scan(const Params& p, int bid, int nb, unsigned char* smem) {
  ScanSmem& sm = *reinterpret_cast<ScanSmem*>(smem);
  const bf16_t* OPS = (const bf16_t*)(p.ws + WS_OPS);
  bf16_t* Y = (bf16_t*)(p.ws + WS_Y);
  const int tid = opaque_tid();
  const int q = tid & 15, rp = tid >> 4;
  for (int u = bid; u < 256; u += nb) {
    const int half = u & 1, h = (u >> 1) & 7, b = (u >> 4) & 7, d = u >> 7;
    const bf16_t* base = OPS + (size_t)(b * NH_ + h) * SEQA * OPS_REC;
    const int f_omw = d ? F_OMW1 : F_OMW0, f_b = d ? F_B1 : F_B0, f_kd = d ? F_KD1 : F_KD0;
    float S[2][4];
#pragma unroll
    for (int i = 0; i < 2; ++i)
#pragma unroll
      for (int j = 0; j < 4; ++j) S[i][j] = 0.f;
    constexpr int NCHUNK = SEQA / SC_T;
    constexpr int NPIECE = SC_T * 44;
    auto chunk_slo = [&](int c) -> int {
      const int i0 = c * SC_T;
      if (d == 0) return i0;
      const int ilast = i0 + SC_T - 1;
      return (ilast < LC_) ? (LC_ - 1 - ilast) : (SEQA + LC_ - 1 - ilast);
    };
    constexpr int NSTG = (NPIECE + 255) / 256;
    uint4 stg[NSTG];
    auto gload = [&](int c) {
      const int slo = chunk_slo(c);
#pragma unroll
      for (int i = 0; i < NSTG; ++i) {
        const int pc = tid + i * 256;
        if (pc < NPIECE) {
          const int j = pc / 44, pi = pc % 44;
          const bf16_t* rec = base + (size_t)(slo + j) * OPS_REC;
          int off;
          if (pi < 40) {
            const int f = pi >> 3;
            const int fld = (f == 0) ? F_KK : (f == 1) ? f_omw : (f == 2) ? f_b : (f == 3) ? f_kd : F_R;
            off = fld * 64 + (pi & 7) * 8;
          } else off = F_V * 64 + half * 32 + (pi - 40) * 8;
          stg[i] = *reinterpret_cast<const uint4*>(rec + off);
        }
      }
    };
    auto lstore = [&](int buf) {
#pragma unroll
      for (int i = 0; i < NSTG; ++i) {
        const int pc = tid + i * 256;
        if (pc < NPIECE) {
          const int j = pc / 44, pi = pc % 44;
          const int f = (pi < 40) ? (pi >> 3) : 5;
          float v[8] = {lo2f(stg[i].x), hi2f(stg[i].x), lo2f(stg[i].y), hi2f(stg[i].y), lo2f(stg[i].z), hi2f(stg[i].z), lo2f(stg[i].w), hi2f(stg[i].w)};
          if (f == 0) {
#pragma unroll
            for (int e = 0; e < 8; ++e) v[e] = -v[e];
          } else if (f == 1) {
#pragma unroll
            for (int e = 0; e < 8; ++e) v[e] = 1.f - v[e];
          }
          float* dst = &sm.ops[buf][j][(pi < 40) ? (f * 64 + (pi & 7) * 8) : (320 + (pi - 40) * 8)];
          *reinterpret_cast<float4*>(dst) = make_float4(v[0], v[1], v[2], v[3]);
          *reinterpret_cast<float4*>(dst + 4) = make_float4(v[4], v[5], v[6], v[7]);
        }
      }
    };
    gload(0);
    lstore(0);
    __syncthreads();
    for (int c = 0; c < NCHUNK; ++c) {
      const int cur = c & 1;
      if (c + 1 < NCHUNK) gload(c + 1);
      const bool latent = (c * SC_T) >= LC_;
      for (int i = 0; i < SC_T; ++i) {
        const int j = d ? (SC_T - 1 - i) : i;
        const float* o = sm.ops[cur][j];
        const float4 a4 = *reinterpret_cast<const float4*>(o + 4 * q);
        const float4 w4 = *reinterpret_cast<const float4*>(o + 64 + 4 * q);
        const float4 b4 = *reinterpret_cast<const float4*>(o + 128 + 4 * q);
        const float4 k4 = *reinterpret_cast<const float4*>(o + 192 + 4 * q);
        const float4 r4 = *reinterpret_cast<const float4*>(o + 256 + 4 * q);
        const float2 v2 = *reinterpret_cast<const float2*>(o + 320 + 2 * rp);
        float yv[2];
#pragma unroll
        for (int r = 0; r < 2; ++r) {
          float sa = S[r][0] * a4.x + S[r][1] * a4.y + S[r][2] * a4.z + S[r][3] * a4.w;
          sa = allreduce16(sa);
          const float vv = r ? v2.y : v2.x;
          S[r][0] = S[r][0] * w4.x + (sa * b4.x + vv * k4.x);
          S[r][1] = S[r][1] * w4.y + (sa * b4.y + vv * k4.y);
          S[r][2] = S[r][2] * w4.z + (sa * b4.z + vv * k4.z);
          S[r][3] = S[r][3] * w4.w + (sa * b4.w + vv * k4.w);
          float y = S[r][0] * r4.x + S[r][1] * r4.y + S[r][2] * r4.z + S[r][3] * r4.w;
          yv[r] = allreduce16(y);
        }
        if (latent && q == 0) *reinterpret_cast<float2*>(&sm.ybuf[j][2 * rp]) = make_float2(yv[0], yv[1]);
      }
      __syncthreads();
      if (latent) {
        const int slo = chunk_slo(c);
        const int j = tid >> 3, e = (tid & 7) * 4;
        if (j < SC_T) {
          const float4 yv = *reinterpret_cast<const float4*>(&sm.ybuf[j][e]);
          const int t = slo + j - LC_;
          uint2 o;
          o.x = pack2(yv.x, yv.y);
          o.y = pack2(yv.z, yv.w);
          *reinterpret_cast<uint2*>(Y + ((size_t)d * NLAT + (size_t)b * L_ + t) * 512 + h * 64 + half * 32 + e) = o;
        }
      }
      if (c + 1 < NCHUNK) lstore(cur ^ 1);
      __syncthreads();
    }
  }
}

__device__ void ph_combine(const Params& p, int bid, int nb) {
  bf16_t* Y = (bf16_t*)(p.ws + WS_Y);
  const bf16_t* OPS = (const bf16_t*)(p.ws + WS_OPS);
  const bf16_t* GR = (const bf16_t*)(p.ws + WS_GR);
  const float* COEF = (const float*)(p.ws + WS_COEF);
  const int tid = opaque_tid();
  const int cg = tid & 15, grp = tid >> 4;
  for (int it = bid * 16 + grp; it < NLAT * NH_; it += nb * 16) {
    const int h = it & 7, m = it >> 3;
    const int b = m / L_, t = m % L_;
    const size_t off = (size_t)m * 512 + h * 64 + cg * 4;
    const uint2 yf = *reinterpret_cast<const uint2*>(Y + off);
    const uint2 yb = *reinterpret_cast<const uint2*>(Y + (size_t)NLAT * 512 + off);
    float y[4] = {lo2f(yf.x) + lo2f(yb.x), hi2f(yf.x) + hi2f(yb.x), lo2f(yf.y) + lo2f(yb.y), hi2f(yf.y) + hi2f(yb.y)};
    const float mean = allreduce16(y[0] + y[1] + y[2] + y[3]) * (1.f / 64.f);
    float vs = 0.f;
#pragma unroll
    for (int i = 0; i < 4; ++i) { y[i] -= mean; vs += y[i] * y[i]; }
    const float rstd = rsqrtf(allreduce16(vs) * (1.f / 64.f) + 64e-5f);
    const uint2 vv = *reinterpret_cast<const uint2*>(OPS + ((size_t)(b * NH_ + h) * SEQA + LC_ + t) * OPS_REC + F_V * 64 + cg * 4);
    const float v_[4] = {lo2f(vv.x), hi2f(vv.x), lo2f(vv.y), hi2f(vv.y)};
    const uint2 gg = *reinterpret_cast<const uint2*>(GR + (size_t)(NCTX + m) * 512 + h * 64 + cg * 4);
    const float g_[4] = {lo2f(gg.x), hi2f(gg.x), lo2f(gg.y), hi2f(gg.y)};
    const float cf = COEF[(size_t)m * NH_ + h];
    float o[4];
#pragma unroll
    for (int i = 0; i < 4; ++i) {
      const int ch = h * 64 + cg * 4 + i;
      o[i] = (y[i] * rstd * p.lnx_g[ch] + p.lnx_b[ch] + cf * v_[i]) * siluf_(g_[i]);
    }
    uint2 ov;
    ov.x = pack2(o[0], o[1]);
    ov.y = pack2(o[2], o[3]);
    *reinterpret_cast<uint2*>(Y + off) = ov;
  }
}

struct AL_UChunk {
  const bf16_t* U;
  int m0, g, rows_per_b, chunk0;
  __device__ __forceinline__ uint4 load(int row, int k) const {
    const int mm = m0 + row;
    const int b = mm / rows_per_b, ch = chunk0 + mm % rows_per_b;
    const int s = k >> 4, c0 = k & 15;
    return *reinterpret_cast<const uint4*>(U + (size_t)tokrow(b, ch * 16 + s) * 512 + g * 16 + c0);
  }
};
struct EP_E {
  float* E;
  int m0, n0, g;
  __device__ __forceinline__ void operator()(f32x4 (&acc)[4][4], int wr, int wc, int lane) {
#pragma unroll
    for (int i = 0; i < 4; ++i)
#pragma unroll
      for (int j = 0; j < 4; ++j) {
        const int mm = m0 + wr * 64 + i * 16 + (lane & 15), n = n0 + wc * 64 + j * 16 + 4 * (lane >> 4);
        *reinterpret_cast<float4*>(E + ((size_t)mm * NG_ + g) * 256 + n) = make_float4(acc[i][j][0], acc[i][j][1], acc[i][j][2], acc[i][j][3]);
      }
  }
};
__device__ void ph_s5_e(const Params& p, int bid, int nb, unsigned char* smem) {
  const bf16_t* U = (const bf16_t*)(p.ws + WS_U);
  const bf16_t* G1 = (const bf16_t*)(p.ws + WS_G1);
  float* E = (float*)((unsigned char*)p.out + DO_E);
  constexpr int MT = (B_ * NCH_ALL) / 128;
  for (int t = bid; t < NG_ * MT * 2; t += nb) {
    const int nt = t & 1, mt = (t >> 1) % MT, g = (t >> 1) / MT;
    AL_UChunk al{U, mt * 128, g, NCH_ALL, 0};
    BL_Rows bl{G1 + ((size_t)g * 256 + nt * 128) * 256, 256};
    EP_E ep{E, mt * 128, nt * 128, g};
    gemm_tile(al, bl, ep, 256, smem);
  }
}

__device__ void ph_s5_carry(const Params& p, int bid, int nb) {
  float* E = (float*)((unsigned char*)p.out + DO_E);
  const float2* AP = (const float2*)(p.ws + WS_AP);
  for (int i = bid * 256 + opaque_tid(); i < B_ * NG_ * 2 * NP_; i += nb * 256) {
    const int pp = i & 63, d = (i >> 6) & 1, g = (i >> 7) & 31, b = i >> 12;
    const float2 a16 = AP[(size_t)((d * NG_ + g) * NP_ + pp) * 17 + 16];
    float hr = 0.f, hi = 0.f;
    float* base = E + ((size_t)b * NCH_ALL * NG_ + g) * 256 + d * 128 + pp;
    for (int step = 0; step < NCH_ALL; ++step) {
      int ch;
      if (d == 0) ch = step;
      else ch = (step < NCH_CTX) ? (NCH_CTX - 1 - step) : (NCH_ALL + NCH_CTX - 1 - step);
      float* e = base + (size_t)ch * NG_ * 256;
      const float er = e[0], ei = e[64];
      e[0] = hr; e[64] = hi;
      const float nr = a16.x * hr - a16.y * hi + er;
      const float ni = a16.x * hi + a16.y * hr + ei;
      hr = nr; hi = ni;
    }
  }
}

struct AL_S5Out {
  const bf16_t* U;
  const float* E;
  int m0, g;
  __device__ __forceinline__ uint4 load(int row, int k) const {
    const int mm = m0 + row;
    const int b = mm >> 8, lc = mm & 255;
    if (k < 256) {
      const int s = k >> 4, c0 = k & 15;
      return *reinterpret_cast<const uint4*>(U + (size_t)(NCTX + b * L_ + lc * 16 + s) * 512 + g * 16 + c0);
    }
    const float* e = E + ((size_t)(b * NCH_ALL + NCH_CTX + lc) * NG_ + g) * 256 + (k - 256);
    const float4 e0 = *reinterpret_cast<const float4*>(e), e1 = *reinterpret_cast<const float4*>(e + 4);
    uint4 o;
    o.x = pack2(e0.x, e0.y); o.y = pack2(e0.z, e0.w); o.z = pack2(e1.x, e1.y); o.w = pack2(e1.z, e1.w);
    return o;
  }
};
struct EP_S5Out {
  const bf16_t* U;
  bf16_t* YS5;
  const float* dpar;
  int m0, n0, g;
  __device__ __forceinline__ void operator()(f32x4 (&acc)[4][4], int wr, int wc, int lane) {
#pragma unroll
    for (int i = 0; i < 4; ++i)
#pragma unroll
      for (int j = 0; j < 4; ++j) {
        const int mm = m0 + wr * 64 + i * 16 + (lane & 15), n = n0 + wc * 64 + j * 16 + 4 * (lane >> 4);
        const int b = mm >> 8, lc = mm & 255, sp = n >> 4, cp = n & 15;
        const size_t tok = (size_t)b * L_ + lc * 16 + sp;
        const uint2 uu = *reinterpret_cast<const uint2*>(U + (NCTX + tok) * 512 + g * 16 + cp);
        const float u_[4] = {lo2f(uu.x), hi2f(uu.x), lo2f(uu.y), hi2f(uu.y)};
        float o[4];
#pragma unroll
        for (int r = 0; r < 4; ++r) o[r] = gelu_tanh(acc[i][j][r] + dpar[g * 16 + cp + r] * u_[r]);
        uint2 ov;
        ov.x = pack2(o[0], o[1]);
        ov.y = pack2(o[2], o[3]);
        *reinterpret_cast<uint2*>(YS5 + tok * 512 + g * 16 + cp) = ov;
      }
  }
};
__device__ void ph_s5_out(const Params& p, int bid, int nb, unsigned char* smem) {
  const bf16_t* U = (const bf16_t*)(p.ws + WS_U);
  const bf16_t* G2 = (const bf16_t*)(p.ws + WS_G2);
  const float* E = (const float*)((const unsigned char*)p.out + DO_E);
  bf16_t* YS5 = (bf16_t*)((unsigned char*)p.out + DO_YS5);
  constexpr int MT = (B_ * 256) / 128;
  for (int t = bid; t < NG_ * MT * 2; t += nb) {
    const int nt = t & 1, mt = (t >> 1) % MT, g = (t >> 1) / MT;
    AL_S5Out al{U, E, mt * 128, g};
    BL_Rows bl{G2 + ((size_t)g * 256 + nt * 128) * 512, 512};
    EP_S5Out ep{U, YS5, p.s5_d, mt * 128, nt * 128, g};
    gemm_tile(al, bl, ep, 512, smem);
  }
}

struct AL_Rows {
  const bf16_t* base;
  int ld;
  __device__ __forceinline__ uint4 load(int row, int k) const { return *reinterpret_cast<const uint4*>(base + (size_t)row * ld + k); }
};
struct BL_Glu {
  const bf16_t* WT;
  int nb64;
  __device__ __forceinline__ uint4 load(int col, int k) const {
    const int wcj = col >> 6, jj = col & 63;
    const int n = (jj < 32) ? nb64 * 64 + wcj * 32 + jj : 512 + nb64 * 64 + wcj * 32 + (jj - 32);
    return *reinterpret_cast<const uint4*>(WT + (size_t)n * 512 + k);
  }
};
struct EP_Glu {
  const bf16_t* GS;
  bf16_t* YS;
  int nb64;
  __device__ __forceinline__ void operator()(f32x4 (&acc)[4][4], int wr, int wc, int lane) {
#pragma unroll
    for (int i = 0; i < 4; ++i)
#pragma unroll
      for (int jt = 0; jt < 2; ++jt) {
        const int row = wr * 64 + i * 16 + (lane & 15);
        const int ch = nb64 * 64 + wc * 32 + jt * 16 + 4 * (lane >> 4);
        const uint2 gg = *reinterpret_cast<const uint2*>(GS + (size_t)row * 512 + ch);
        const float g_[4] = {lo2f(gg.x), hi2f(gg.x), lo2f(gg.y), hi2f(gg.y)};
        float o[4];
#pragma unroll
        for (int r = 0; r < 4; ++r) o[r] = acc[i][jt][r] * sigmoidf_(acc[i][jt + 2][r]) * siluf_(g_[r]);
        uint2 ov;
        ov.x = pack2(o[0], o[1]);
        ov.y = pack2(o[2], o[3]);
        *reinterpret_cast<uint2*>(YS + (size_t)row * 512 + ch) = ov;
      }
  }
};
__device__ void ph_glu(const Params& p, int bid, int nb, unsigned char* smem) {
  const bf16_t* YS5 = (const bf16_t*)((const unsigned char*)p.out + DO_YS5);
  const bf16_t* WT = (const bf16_t*)(p.ws + WS_WGLUT);
  const bf16_t* GS = (const bf16_t*)(p.ws + WS_GS);
  bf16_t* YS = (bf16_t*)(p.ws + WS_U);
  for (int t = bid; t < (NLAT / 128) * 8; t += nb) {
    const int nbk = t & 7, mt = t >> 3;
    AL_Rows al{YS5 + (size_t)mt * 128 * 512, 512};
    BL_Glu bl{WT, nbk};
    EP_Glu ep{GS + (size_t)(NCTX + mt * 128) * 512, YS + (size_t)mt * 128 * 512, nbk};
    gemm_tile(al, bl, ep, 512, smem);
  }
}

struct AL_Cat {
  const bf16_t* YR;
  const bf16_t* YS;
  __device__ __forceinline__ uint4 load(int row, int k) const {
    return (k < 512) ? *reinterpret_cast<const uint4*>(YR + (size_t)row * 512 + k) : *reinterpret_cast<const uint4*>(YS + (size_t)row * 512 + (k - 512));
  }
};
struct EP_Out {
  const float* x;
  float* out;
  const float* gate;
  float* rowss;
  __device__ __forceinline__ void operator()(f32x4 (&acc)[4][4], int wr, int wc, int lane) {
#pragma unroll
    for (int i = 0; i < 4; ++i) {
      const int row = wr * 64 + i * 16 + (lane & 15);
      float ss = 0.f;
#pragma unroll
      for (int j = 0; j < 4; ++j) {
        const int col = wc * 64 + j * 16 + 4 * (lane >> 4);
        const float4 xv = *reinterpret_cast<const float4*>(x + (size_t)row * D_ + col);
        const float4 gv = *reinterpret_cast<const float4*>(gate + col);
        float4 o;
        o.x = xv.x + gv.x * acc[i][j][0];
        o.y = xv.y + gv.y * acc[i][j][1];
        o.z = xv.z + gv.z * acc[i][j][2];
        o.w = xv.w + gv.w * acc[i][j][3];
        ss += o.x * o.x + o.y * o.y + o.z * o.z + o.w * o.w;
        *reinterpret_cast<float4*>(out + (size_t)row * D_ + col) = o;
      }
      ss += __shfl_xor(ss, 16);
      ss += __shfl_xor(ss, 32);
      if (lane < 16) atomicAdd(rowss + row, ss);
    }
  }
};
__device__ void ph_out(const Params& p, int bid, int nb, unsigned char* smem) {
  const bf16_t* YR = (const bf16_t*)(p.ws + WS_Y);
  const bf16_t* YS = (const bf16_t*)(p.ws + WS_U);
  const bf16_t* WT = (const bf16_t*)(p.ws + WS_WOUTT);
  const float* MOD = (const float*)(p.ws + WS_MOD);
  float* ROWSS = (float*)(p.ws + WS_ROWSS);
  for (int t = bid; t < (NLAT / 128) * 8; t += nb) {
    const int nt = t & 7, mt = t >> 3;
    const int m0 = mt * 128, n0 = nt * 128, b = m0 / L_;
    AL_Cat al{YR + (size_t)m0 * 512, YS + (size_t)m0 * 512};
    BL_Rows bl{WT + (size_t)n0 * 1024, 1024};
    EP_Out ep{p.x + (size_t)m0 * D_ + n0, p.out + (size_t)m0 * D_ + n0, MOD + b * 3072 + 2048 + n0, ROWSS + m0};
    gemm_tile(al, bl, ep, 1024, smem);
  }
}

__device__ void ph_final(const Params& p, int bid, int nb) {
  const float* ROWSS = (const float*)(p.ws + WS_ROWSS);
  const int tid = opaque_tid();
  const int lane = tid & 63, w = tid >> 6;
  for (int m = bid * 4 + w; m < NLAT; m += nb * 4) {
    const float r = rsqrtf(ROWSS[m] * (1.f / D_) + 1e-6f);
    float* row = p.out + (size_t)m * D_;
#pragma unroll
    for (int i = 0; i < 4; ++i) {
      float4 v = *reinterpret_cast<float4*>(row + i * 256 + lane * 4);
      const float4 g = *reinterpret_cast<const float4*>(p.final_g + i * 256 + lane * 4);
      v.x *= r * g.x; v.y *= r * g.y; v.z *= r * g.z; v.w *= r * g.w;
      *reinterpret_cast<float4*>(row + i * 256 + lane * 4) = v;
    }
  }
}

#define XB_TMO      128
#define XB_XCNT(j)  (256  + 64 * (j))
#define XB_XSUB(j)  (1280 + 64 * (j))
#define XB_XGEN(j)  (2304 + 64 * (j))
#define XB_TOP      3328
#define XB_TOPGEN   3392
#define XCD_BAR_WORDS 3456
#define XB_SPIN_CAP (1u << 22)
#define LAS __attribute__((address_space(3)))
__device__ __forceinline__ unsigned xb_ld(unsigned* p) { return __hip_atomic_load(p, __ATOMIC_RELAXED, __HIP_MEMORY_SCOPE_AGENT); }
__device__ __forceinline__ unsigned xb_add(unsigned* p, unsigned v) { return __hip_atomic_fetch_add(p, v, __ATOMIC_RELAXED, __HIP_MEMORY_SCOPE_AGENT); }
__device__ __forceinline__ unsigned xb_xcc_id() { return (unsigned)__builtin_amdgcn_s_getreg((3 << 11) | 20) & 0xFu; }
#define XB_SPIN(cond, bar) do { unsigned _sp = 0; while (cond) { __builtin_amdgcn_s_sleep(1); \
    if ((++_sp & 255u) == 0u) { if (xb_ld(&(bar)[XB_TMO])) break; if (_sp > XB_SPIN_CAP) { atomicAdd(&(bar)[XB_TMO], 1u); break; } } } } while (0)
struct XcdBarrier { unsigned* bar; unsigned x; volatile LAS unsigned* st; };
__device__ __forceinline__ XcdBarrier xcd_barrier_post(unsigned* bar, volatile LAS unsigned* st) {
  XcdBarrier b; b.bar = bar; b.x = xb_xcc_id(); b.st = st;
  if (threadIdx.x == 0) (void)xb_add(&bar[XB_XCNT(b.x)], 1u);
  return b;
}
__device__ __forceinline__ void xcd_barrier_complete(unsigned* bar, unsigned x, unsigned& nloc, unsigned& nx) {
  const unsigned G = gridDim.x * gridDim.y * gridDim.z;
  unsigned sum, cnt, mine, sp = 0u;
  for (;;) {
    sum = 0u; cnt = 0u; mine = 0u;
#pragma unroll
    for (unsigned j = 0; j < 16; ++j) { const unsigned c = xb_ld(&bar[XB_XCNT(j)]); sum += c; cnt += (c > 0u) ? 1u : 0u; mine = (j == x) ? c : mine; }
    if (sum == G) break;
    __builtin_amdgcn_s_sleep(1);
    if ((++sp & 255u) == 0u) { if (xb_ld(&bar[XB_TMO])) break; if (sp > XB_SPIN_CAP) { atomicAdd(&bar[XB_TMO], 1u); break; } }
  }
  nloc = mine > 0u ? mine : 1u; nx = cnt > 0u ? cnt : 1u;
}
__device__ __forceinline__ void xcd_barrier(const XcdBarrier& b) {
  asm volatile("s_waitcnt vmcnt(0)" ::: "memory");
  __syncthreads();
  if (threadIdx.x == 0) {
    unsigned* bar = b.bar;
    __builtin_amdgcn_s_waitcnt(0);
    unsigned nloc = b.st[0], nx = b.st[1];
    if (nloc == 0u) { xcd_barrier_complete(bar, b.x, nloc, nx); b.st[0] = nloc; b.st[1] = nx; }
    const unsigned old = xb_add(&bar[XB_XSUB(b.x)], 1u);
    const unsigned gen = old / nloc;
    if (old + 1u == (gen + 1u) * nloc) {
      __builtin_amdgcn_fence(__ATOMIC_RELEASE, "agent");
      asm volatile("s_waitcnt vmcnt(0)" ::: "memory");
      const unsigned og = xb_add(&bar[XB_TOP], 1u);
      const unsigned tg = og / nx;
      if (og + 1u == (tg + 1u) * nx) xb_add(&bar[XB_TOPGEN], 1u);
      else XB_SPIN(xb_ld(&bar[XB_TOPGEN]) == tg, bar);
      __builtin_amdgcn_fence(__ATOMIC_ACQUIRE, "agent");
      xb_add(&bar[XB_XGEN(b.x)], 1u);
      asm volatile("s_waitcnt vmcnt(0)" ::: "memory");
    } else {
      XB_SPIN(xb_ld(&bar[XB_XGEN(b.x)]) == gen, bar);
      __builtin_amdgcn_fence(__ATOMIC_ACQUIRE, "agent");
      asm volatile("s_waitcnt vmcnt(0)" ::: "memory");
    }
  }
  __syncthreads();
}

constexpr int SMEM_WORK = 47104;
constexpr int SMEM_BYTES = SMEM_WORK + 16;
static_assert(sizeof(ScanSmem) <= SMEM_WORK && sizeof(GemmSmem) <= SMEM_WORK && sizeof(PrepSmem) <= SMEM_WORK, "LDS budget");
constexpr int BLOCKS_PER_CU = 3;

__global__ void __launch_bounds__(256, BLOCKS_PER_CU) mega_fwd(Params p) {
  extern __shared__ __attribute__((aligned(16))) unsigned char smem[];
  volatile LAS unsigned* st = (volatile LAS unsigned*)(smem + SMEM_WORK);
  if (threadIdx.x < 4) st[threadIdx.x] = 0u;
  __syncthreads();
  XcdBarrier bar = xcd_barrier_post((unsigned*)(p.ws + WS_CTL), st);
  const int bid = blockIdx.x, nb = gridDim.x;
  ph_mod(p, bid, nb);
  ph_transpose(p, bid, nb, smem);
  ph_rs(p, bid, nb);
  ph_s5_ap(p, bid, nb);
  xcd_barrier(bar);
  ph_gmsh(p, bid, nb);
  ph_s5_kt(p, bid, nb);
  xcd_barrier(bar);
  ph_s5_g(p, bid, nb);
  ph_gemm1(p, bid, nb, smem);
  xcd_barrier(bar);
  ph_prep(p, bid, nb, smem);
  xcd_barrier(bar);
  ph_s5_e(p, bid, nb, smem);
  xcd_barrier(bar);
  ph_s5_carry(p, bid, nb);
  xcd_barrier(bar);
  ph_s5_out(p, bid, nb, smem);
  xcd_barrier(bar);
  ph_glu(p, bid, nb, smem);
  xcd_barrier(bar);
  ph_scan(p, bid, nb, smem);
  xcd_barrier(bar);
  ph_combine(p, bid, nb);
  xcd_barrier(bar);
  ph_out(p, bid, nb, smem);
  xcd_barrier(bar);
  ph_final(p, bid, nb);
}

extern "C" void kernel_launch(void* const* d_in, const int* in_sizes, int n_in, void* d_out, int out_size, void* d_ws, size_t ws_size, hipStream_t stream) {
  (void)in_sizes; (void)n_in; (void)out_size;
  if (ws_size < WS_END) return;
  static int grid = 0;
  if (grid == 0) {
    int dev = 0, cus = 0, per_cu = 0;
    (void)hipGetDevice(&dev);
    (void)hipDeviceGetAttribute(&cus, hipDeviceAttributeMultiprocessorCount, dev);
    (void)hipFuncSetAttribute((const void*)mega_fwd, hipFuncAttributeMaxDynamicSharedMemorySize, SMEM_BYTES);
    (void)hipOccupancyMaxActiveBlocksPerMultiprocessor(&per_cu, (const void*)mega_fwd, 256, SMEM_BYTES);
    if (per_cu > BLOCKS_PER_CU) per_cu = BLOCKS_PER_CU;
    if (per_cu < 1) per_cu = 1;
    grid = cus * per_cu;
  }
  Params p{};
  const float** f = reinterpret_cast<const float**>(&p);
  for (int i = 0; i < 29; ++i) f[i] = (const float*)d_in[i];
  p.out = (float*)d_out;
  p.ws = (unsigned char*)d_ws;
  (void)hipMemsetAsync((char*)d_ws + WS_CTL, 0, WS_ZERO_END - WS_CTL, stream);
  void* args[] = {&p};
  (void)hipLaunchCooperativeKernel((const void*)mega_fwd, dim3(grid), dim3(256), args, SMEM_BYTES, stream);
}
```

```cpp
#include <hip/hip_runtime.h>
#include <stdint.h>

constexpr int B_ = 8, L_ = 4096, LC_ = 256, D_ = 1024, DIN_ = 3328, SW_ = 1792, DR_ = 512, DS_ = 512;
constexpr int NH_ = 8, HD_ = 64, NG_ = 32, NP_ = 64, TS5 = 16;
constexpr int SEQA = LC_ + L_;
constexpr int NTOK = B_ * SEQA;
constexpr int NCTX = B_ * LC_;
constexpr int NLAT = B_ * L_;
constexpr int NCH_ALL = SEQA / TS5;
constexpr int NCH_CTX = LC_ / TS5;

typedef unsigned short bf16_t;
using bf16x8 = __attribute__((ext_vector_type(8))) short;
using f32x4 = __attribute__((ext_vector_type(4))) float;
using f32x16 = __attribute__((ext_vector_type(16))) float;
using u32x4 = __attribute__((ext_vector_type(4))) unsigned;
typedef __bf16 bf16x2_t __attribute__((ext_vector_type(2)));
typedef float f32x2_t __attribute__((ext_vector_type(2)));

constexpr size_t al256(size_t x) { return (x + 255) & ~(size_t)255; }
constexpr size_t WS_GR = 0;
constexpr size_t WS_U = WS_GR + al256((size_t)NTOK * 512 * 2);
constexpr size_t WS_GS = WS_U + al256((size_t)NTOK * 512 * 2);
constexpr size_t WS_TB = WS_GS + al256((size_t)NTOK * 512 * 2);
constexpr size_t WS_VT = WS_TB + al256((size_t)2 * B_ * NH_ * (SEQA / 32) * (4 * 32 * 64 * 2 + 256));
constexpr size_t WS_Y = WS_VT + al256((size_t)B_ * NH_ * SEQA * 64 * 2);
constexpr size_t WS_WINT = WS_Y + al256((size_t)2 * NLAT * 512 * 2);
constexpr size_t WS_WGLUT = WS_WINT + al256((size_t)DIN_ * D_ * 2);
constexpr size_t WS_WOUTT = WS_WGLUT + al256((size_t)1024 * 512 * 2);
constexpr size_t WS_W2T = WS_WOUTT + al256((size_t)1024 * 1024 * 2);
constexpr size_t WS_A2T = WS_W2T + al256((size_t)2 * 512 * 64 * 2);
constexpr size_t WS_G1 = WS_A2T + al256((size_t)2 * 512 * 64 * 2);
constexpr size_t WS_G2 = WS_G1 + al256((size_t)NG_ * 256 * 256 * 2);
constexpr size_t WS_AP = WS_G2 + al256((size_t)NG_ * 256 * 512 * 2);
constexpr size_t WS_BBAR = WS_AP + al256((size_t)2 * NG_ * NP_ * 17 * 8);
constexpr size_t WS_KT = WS_BBAR + al256((size_t)2 * NG_ * NP_ * 16 * 8);
constexpr size_t WS_CTL = WS_KT + al256((size_t)2 * NG_ * 16 * 256 * 4);
constexpr size_t WS_MOD = WS_CTL + 16384;
constexpr size_t WS_ROWSS = WS_MOD + al256((size_t)9 * 3072 * 4);
constexpr size_t WS_ZERO_END = WS_ROWSS + al256((size_t)NLAT * 4);
constexpr size_t WS_GM = WS_ZERO_END;
constexpr size_t WS_SH = WS_GM + al256((size_t)9 * 1024 * 4);
constexpr size_t WS_RS = WS_SH + al256((size_t)9 * 1024 * 4);
constexpr size_t WS_COEF = WS_RS + al256((size_t)NTOK * 4);
constexpr size_t WS_END = WS_COEF + al256((size_t)NLAT * 8 * 4);
constexpr size_t DO_ZS = 0;
constexpr size_t DO_E = 0;
constexpr size_t DO_YS5 = al256((size_t)B_ * NCH_ALL * NG_ * 256 * 4);

struct Params {
  const float *x, *c, *ctx, *c_ctx, *norm_g, *w_ada, *b_ada, *w_in, *mu, *w0, *w2, *a0, *a2, *k_k, *k_a, *r_k, *lnx_g, *lnx_b;
  const float *lam_re, *lam_im, *log_dt, *b_re, *b_im, *c_re, *c_im, *s5_d, *w_glu, *w_out, *final_g;
  float* out;
  unsigned char* ws;
};

__device__ __forceinline__ float bf2f(bf16_t h) { return __uint_as_float(((unsigned)h) << 16); }
__device__ __forceinline__ unsigned pack2(float a, float b) {
  f32x2_t v = {a, b};
  bf16x2_t r = __builtin_convertvector(v, bf16x2_t);
  return __builtin_bit_cast(unsigned, r);
}
__device__ __forceinline__ float lo2f(unsigned u) { return __uint_as_float(u << 16); }
__device__ __forceinline__ float hi2f(unsigned u) { return __uint_as_float(u & 0xffff0000u); }
template <int CTRL>
__device__ __forceinline__ float dpp_mov(float v) {
  return __builtin_bit_cast(float, __builtin_amdgcn_update_dpp(0, __builtin_bit_cast(int, v), CTRL, 0xF, 0xF, true));
}
__device__ __forceinline__ float allreduce16(float v) {
  v += dpp_mov<0xB1>(v);
  v += dpp_mov<0x4E>(v);
  v += dpp_mov<0x141>(v);
  v += dpp_mov<0x140>(v);
  return v;
}
__device__ __forceinline__ int opaque_tid() {
  int t = threadIdx.x & 255;
  asm volatile("" : "+v"(t));
  return t;
}
__device__ __forceinline__ float sigmoidf_(float x) { return 1.f / (1.f + __expf(-x)); }
__device__ __forceinline__ float siluf_(float x) { return x / (1.f + __expf(-x)); }
__device__ __forceinline__ float gelu_tanh(float y) {
  float t = 0.7978845608028654f * (y + 0.044715f * y * y * y);
  float e = __expf(2.f * t);
  float th = 1.f - 2.f / (e + 1.f);
  return 0.5f * y * (1.f + th);
}
__device__ __forceinline__ int tokrow(int b, int s) {
  return s < LC_ ? b * LC_ + s : NCTX + b * L_ + (s - LC_);
}

struct GemmSmem {
  bf16_t A[2][128][40];
  bf16_t B[2][128][40];
};
template <class AL, class BL, class EP>
__device__ __forceinline__ void gemm_tile(const AL& al, const BL& bl, EP& ep, int K, unsigned char* smem_raw) {
  GemmSmem& sm = *reinterpret_cast<GemmSmem*>(smem_raw);
  const int tid = opaque_tid(), lane = tid & 63, w = tid >> 6;
  const int wr = w >> 1, wc = w & 1;
  f32x4 acc[4][4];
#pragma unroll
  for (int i = 0; i < 4; ++i)
#pragma unroll
    for (int j = 0; j < 4; ++j) acc[i][j] = (f32x4){0.f, 0.f, 0.f, 0.f};
  const int r0 = tid >> 2, kg = (tid & 3) * 8;
  uint4 ra[2], rb[2];
  const int nk = K >> 5;
#pragma unroll
  for (int i = 0; i < 2; ++i) {
    ra[i] = al.load(r0 + i * 64, kg);
    rb[i] = bl.load(r0 + i * 64, kg);
  }
#pragma unroll
  for (int i = 0; i < 2; ++i) {
    *reinterpret_cast<uint4*>(&sm.A[0][r0 + i * 64][kg]) = ra[i];
    *reinterpret_cast<uint4*>(&sm.B[0][r0 + i * 64][kg]) = rb[i];
  }
  __syncthreads();
  for (int kt = 0; kt < nk; ++kt) {
    const int cur = kt & 1;
    if (kt + 1 < nk) {
#pragma unroll
      for (int i = 0; i < 2; ++i) {
        ra[i] = al.load(r0 + i * 64, (kt + 1) * 32 + kg);
        rb[i] = bl.load(r0 + i * 64, (kt + 1) * 32 + kg);
      }
    }
    bf16x8 af[4], bfr[4];
#pragma unroll
    for (int i = 0; i < 4; ++i) af[i] = *reinterpret_cast<const bf16x8*>(&sm.A[cur][wr * 64 + i * 16 + (lane & 15)][(lane >> 4) * 8]);
#pragma unroll
    for (int j = 0; j < 4; ++j) bfr[j] = *reinterpret_cast<const bf16x8*>(&sm.B[cur][wc * 64 + j * 16 + (lane & 15)][(lane >> 4) * 8]);
#pragma unroll
    for (int i = 0; i < 4; ++i)
#pragma unroll
      for (int j = 0; j < 4; ++j) acc[i][j] = __builtin_amdgcn_mfma_f32_16x16x32_bf16(bfr[j], af[i], acc[i][j], 0, 0, 0);
    if (kt + 1 < nk) {
#pragma unroll
      for (int i = 0; i < 2; ++i) {
        *reinterpret_cast<uint4*>(&sm.A[cur ^ 1][r0 + i * 64][kg]) = ra[i];
        *reinterpret_cast<uint4*>(&sm.B[cur ^ 1][r0 + i * 64][kg]) = rb[i];
      }
    }
    __syncthreads();
  }
  ep(acc, wr, wc, lane);
}

__device__ void ph_mod(const Params& p, int bid, int nb) {
  float* MOD = (float*)(p.ws + WS_MOD);
  const int tid = opaque_tid();
  for (int it = bid; it < 12 * 16; it += nb) {
    const int nblk = it % 12, kc = it / 12;
    const int n = nblk * 256 + tid;
    float acc[9];
#pragma unroll
    for (int j = 0; j < 9; ++j) acc[j] = 0.f;
    for (int k = kc * 64; k < kc * 64 + 64; ++k) {
      const float wv = p.w_ada[(size_t)k * 3072 + n];
#pragma unroll
      for (int j = 0; j < 9; ++j) {
        const float cv = (j < 8) ? p.c[j * 1024 + k] : p.c_ctx[k];
        acc[j] += siluf_(cv) * wv;
      }
    }
    const float bias = (kc == 0) ? p.b_ada[n] : 0.f;
#pragma unroll
    for (int j = 0; j < 9; ++j) atomicAdd(&MOD[j * 3072 + n], acc[j] + bias);
  }
}

__device__ void ph_gmsh(const Params& p, int bid, int nb) {
  const float* MOD = (const float*)(p.ws + WS_MOD);
  float* GM = (float*)(p.ws + WS_GM);
  float* SH = (float*)(p.ws + WS_SH);
  for (int i = bid * 256 + opaque_tid(); i < 9 * 1024; i += nb * 256) {
    const int j = i >> 10, k = i & 1023;
    GM[i] = p.norm_g[k] * (1.f + MOD[j * 3072 + 1024 + k]);
    SH[i] = MOD[j * 3072 + k];
  }
}

__device__ __forceinline__ void transpose_item(const float* __restrict__ src, int K, int N, bf16_t* __restrict__ dst, int item, float* tile  ) {
  const int nk = K / 32;
  const int kt = item % nk, nt = item / nk;
  const int tid = opaque_tid();
  const int tx = tid & 31, ty = tid >> 5;
#pragma unroll
  for (int i = 0; i < 4; ++i) {
    const int kk = ty + i * 8;
    tile[kk * 33 + tx] = src[(size_t)(kt * 32 + kk) * N + nt * 32 + tx];
  }
  __syncthreads();
#pragma unroll
  for (int i = 0; i < 4; ++i) {
    const int nn = ty + i * 8;
    const float v = tile[tx * 33 + nn];
    f32x2_t vv = {v, 0.f};
    bf16x2_t r = __builtin_convertvector(vv, bf16x2_t);
    dst[(size_t)(nt * 32 + nn) * K + kt * 32 + tx] = (bf16_t)(__builtin_bit_cast(unsigned, r) & 0xffff);
  }
  __syncthreads();
}
__device__ void ph_transpose(const Params& p, int bid, int nb, unsigned char* smem) {
  float* tile = (float*)smem;
  constexpr int I_IN = (D_ / 32) * (DIN_ / 32), I_GLU = (512 / 32) * (1024 / 32), I_OUT = 32 * 32, I_L = (64 / 32) * (512 / 32);
  constexpr int TOT = I_IN + I_GLU + I_OUT + 4 * I_L;
  for (int it = bid; it < TOT; it += nb) {
    int r = it;
    if (r < I_IN) { transpose_item(p.w_in, D_, DIN_, (bf16_t*)(p.ws + WS_WINT), r, tile); continue; }
    r -= I_IN;
    if (r < I_GLU) { transpose_item(p.w_glu, 512, 1024, (bf16_t*)(p.ws + WS_WGLUT), r, tile); continue; }
    r -= I_GLU;
    if (r < I_OUT) { transpose_item(p.w_out, 1024, 1024, (bf16_t*)(p.ws + WS_WOUTT), r, tile); continue; }
    r -= I_OUT;
    const int which = r / I_L, rr = r % I_L;
    const float* src = (which < 2 ? p.w2 : p.a2) + (size_t)(which & 1) * 64 * 512;
    bf16_t* dst = (bf16_t*)(p.ws + (which < 2 ? WS_W2T : WS_A2T)) + (size_t)(which & 1) * 512 * 64;
    transpose_item(src, 64, 512, dst, rr, tile);
  }
}

__device__ void ph_rs(const Params& p, int bid, int nb) {
  float* RS = (float*)(p.ws + WS_RS);
  const int tid = opaque_tid();
  const int lane = tid & 63, w = tid >> 6;
  for (int m = bid * 4 + w; m < NTOK; m += nb * 4) {
    const float* row = (m < NCTX) ? p.ctx + (size_t)m * D_ : p.x + (size_t)(m - NCTX) * D_;
    float s = 0.f;
#pragma unroll
    for (int i = 0; i < 4; ++i) {
      const float4 v = *reinterpret_cast<const float4*>(row + i * 256 + lane * 4);
      s += v.x * v.x + v.y * v.y + v.z * v.z + v.w * v.w;
    }
#pragma unroll
    for (int o = 32; o >= 1; o >>= 1) s += __shfl_xor(s, o);
    if (lane == 0) RS[m] = rsqrtf(s * (1.f / D_) + 1e-6f);
  }
}

__device__ void ph_s5_ap(const Params& p, int bid, int nb) {
  float2* AP = (float2*)(p.ws + WS_AP);
  float2* BB = (float2*)(p.ws + WS_BBAR);
  const int tid = opaque_tid();
  for (int i = bid * 256 + tid; i < 2 * NG_ * NP_ * 32; i += nb * 256) {
    const int n = i & 31, dgp = i >> 5;
    const int pp = dgp & 63, g = (dgp >> 6) & 31, d = dgp >> 11;
    const double dt = exp((double)p.log_dt[d * NG_ + g]);
    const double lr = (double)p.lam_re[(d * NG_ + g) * NP_ + pp], li = (double)p.lam_im[(d * NG_ + g) * NP_ + pp];
    if (n <= 16) {
      const double mag = exp(n * dt * lr);
      AP[(size_t)dgp * 17 + n] = make_float2((float)(mag * cos(n * dt * li)), (float)(mag * sin(n * dt * li)));
    } else if (n < 21) {
      const double mag = exp(dt * lr), ar = mag * cos(dt * li), ai = mag * sin(dt * li);
      const double den = lr * lr + li * li;
      const double fr = ((ar - 1.0) * lr + ai * li) / den, fi = (ai * lr - (ar - 1.0) * li) / den;
#pragma unroll
      for (int cc = 0; cc < 4; ++cc) {
        const int c = (n - 17) * 4 + cc;
        const double br = (double)p.b_re[(g * NP_ + pp) * 16 + c], bi = (double)p.b_im[(g * NP_ + pp) * 16 + c];
        BB[(size_t)dgp * 16 + c] = make_float2((float)(fr * br - fi * bi), (float)(fr * bi + fi * br));
      }
    }
  }
}
__device__ void ph_s5_kt(const Params& p, int bid, int nb) {
  const float2* AP = (const float2*)(p.ws + WS_AP);
  const float2* BB = (const float2*)(p.ws + WS_BBAR);
  float* KT = (float*)(p.ws + WS_KT);
  for (int i = bid * 256 + opaque_tid(); i < 2 * NG_ * 16 * 256; i += nb * 256) {
    const int c = i & 15, cp = (i >> 4) & 15, tau = (i >> 8) & 15, g = (i >> 12) & 31, d = i >> 17;
    float acc = 0.f;
    for (int pp = 0; pp < NP_; ++pp) {
      const float cr = p.c_re[(g * 16 + cp) * NP_ + pp], ci = p.c_im[(g * 16 + cp) * NP_ + pp];
      const float2 a = AP[(size_t)((d * NG_ + g) * NP_ + pp) * 17 + tau];
      const float2 bb = BB[(size_t)((d * NG_ + g) * NP_ + pp) * 16 + c];
      const float qr = cr * a.x - ci * a.y, qi = cr * a.y + ci * a.x;
      acc += qr * bb.x - qi * bb.y;
    }
    KT[i] = acc;
  }
}
__device__ void ph_s5_g(const Params& p, int bid, int nb) {
  const float2* AP = (const float2*)(p.ws + WS_AP);
  const float2* BB = (const float2*)(p.ws + WS_BBAR);
  const float* KT = (const float*)(p.ws + WS_KT);
  bf16_t* G1 = (bf16_t*)(p.ws + WS_G1);
  bf16_t* G2 = (bf16_t*)(p.ws + WS_G2);
  const int n1 = NG_ * 256 * 256, n2 = NG_ * 256 * 512;
  for (int i = bid * 256 + opaque_tid(); i < n1 + n2; i += nb * 256) {
    float val;
    if (i < n1) {
      const int k = i & 255, n = (i >> 8) & 255, g = i >> 16;
      const int s = k >> 4, c = k & 15, d = n >> 7, ri = (n >> 6) & 1, pp = n & 63;
      const int pw = d == 0 ? 15 - s : s;
      const float2 a = AP[(size_t)((d * NG_ + g) * NP_ + pp) * 17 + pw];
      const float2 bb = BB[(size_t)((d * NG_ + g) * NP_ + pp) * 16 + c];
      val = ri == 0 ? a.x * bb.x - a.y * bb.y : a.x * bb.y + a.y * bb.x;
      G1[i] = (bf16_t)(pack2(val, 0.f) & 0xffff);
    } else {
      const int i2 = i - n1;
      const int k = i2 & 511, n = (i2 >> 9) & 255, g = i2 >> 17;
      const int sp = n >> 4, cp = n & 15;
      if (k < 256) {
        const int s = k >> 4, c = k & 15;
        val = 0.f;
        if (s <= sp) val += KT[(((0 * NG_ + g) * 16 + (sp - s)) * 16 + cp) * 16 + c];
        if (s >= sp) val += KT[(((1 * NG_ + g) * 16 + (s - sp)) * 16 + cp) * 16 + c];
      } else {
        const int kk = k - 256, d = kk >> 7, ri = (kk >> 6) & 1, pp = kk & 63;
        const int pw = d == 0 ? sp + 1 : 16 - sp;
        const float2 a = AP[(size_t)((d * NG_ + g) * NP_ + pp) * 17 + pw];
        const float cr = p.c_re[(g * 16 + cp) * NP_ + pp], ci = p.c_im[(g * 16 + cp) * NP_ + pp];
        const float qr = cr * a.x - ci * a.y, qi = cr * a.y + ci * a.x;
        val = ri == 0 ? qr : -qi;
      }
      G2[i2] = (bf16_t)(pack2(val, 0.f) & 0xffff);
    }
  }
}

struct AL_X {
  const float* base;
  const float* rs;
  const float* gm;
  const float* sh;
  __device__ __forceinline__ uint4 load(int row, int k) const {
    const float4 a0 = *reinterpret_cast<const float4*>(base + (size_t)row * D_ + k);
    const float4 a1 = *reinterpret_cast<const float4*>(base + (size_t)row * D_ + k + 4);
    const float4 g0 = *reinterpret_cast<const float4*>(gm + k), g1 = *reinterpret_cast<const float4*>(gm + k + 4);
    const float4 s0 = *reinterpret_cast<const float4*>(sh + k), s1 = *reinterpret_cast<const float4*>(sh + k + 4);
    const float r = rs[row];
    uint4 o;
    o.x = pack2(a0.x * r * g0.x + s0.x, a0.y * r * g0.y + s0.y);
    o.y = pack2(a0.z * r * g0.z + s0.z, a0.w * r * g0.w + s0.w);
    o.z = pack2(a1.x * r * g1.x + s1.x, a1.y * r * g1.y + s1.y);
    o.w = pack2(a1.z * r * g1.z + s1.z, a1.w * r * g1.w + s1.w);
    return o;
  }
};
struct BL_Rows {
  const bf16_t* base;
  int ld;
  __device__ __forceinline__ uint4 load(int col, int k) const { return *reinterpret_cast<const uint4*>(base + (size_t)col * ld + k); }
};
struct EP_Z {
  bf16_t* dst;
  int ld;
  __device__ __forceinline__ void operator()(f32x4 (&acc)[4][4], int wr, int wc, int lane) {
#pragma unroll
    for (int i = 0; i < 4; ++i)
#pragma unroll
      for (int j = 0; j < 4; ++j) {
        const int row = wr * 64 + i * 16 + (lane & 15), col = wc * 64 + j * 16 + 4 * (lane >> 4);
        uint2 o;
        o.x = pack2(acc[i][j][0], acc[i][j][1]);
        o.y = pack2(acc[i][j][2], acc[i][j][3]);
        *reinterpret_cast<uint2*>(dst + (size_t)row * ld + col) = o;
      }
  }
};
__device__ void ph_gemm1(const Params& p, int bid, int nb, unsigned char* smem) {
  const float* RS = (const float*)(p.ws + WS_RS);
  const float* GM = (const float*)(p.ws + WS_GM);
  const float* SH = (const float*)(p.ws + WS_SH);
  const bf16_t* WT = (const bf16_t*)(p.ws + WS_WINT);
  bf16_t* ZS = (bf16_t*)((unsigned char*)p.out + DO_ZS);
  constexpr int NT = DIN_ / 128;
  for (int t = bid; t < (NTOK / 128) * NT; t += nb) {
    const int mt = t / NT, nt = t % NT;
    const int m0 = mt * 128, n0 = nt * 128;
    const int j = (m0 < NCTX) ? 8 : (m0 - NCTX) / L_;
    AL_X al{(m0 < NCTX) ? p.ctx + (size_t)m0 * D_ : p.x + (size_t)(m0 - NCTX) * D_, RS + m0, GM + j * 1024, SH + j * 1024};
    BL_Rows bl{WT + (size_t)n0 * D_, D_};
    EP_Z ep;
    if (n0 < SW_) { ep.dst = ZS + (size_t)m0 * SW_ + n0; ep.ld = SW_; }
    else if (n0 < SW_ + 512) { ep.dst = (bf16_t*)(p.ws + WS_GR) + (size_t)m0 * 512 + (n0 - SW_); ep.ld = 512; }
    else if (n0 < SW_ + 1024) { ep.dst = (bf16_t*)(p.ws + WS_U) + (size_t)m0 * 512 + (n0 - SW_ - 512); ep.ld = 512; }
    else { ep.dst = (bf16_t*)(p.ws + WS_GS) + (size_t)m0 * 512 + (n0 - SW_ - 1024); ep.ld = 512; }
    gemm_tile(al, bl, ep, D_, smem);
  }
}

constexpr int RT_ = 32;
constexpr int NCS = SEQA / RT_;
constexpr int NCS_CTX = LC_ / RT_;
constexpr int TB_REC = 4 * RT_ * 64 * 2 + 256;
__device__ __forceinline__ int pos_(int k) { return (k & ~12) | ((k & 8) >> 1) | ((k & 4) << 1); }
struct PrepSmem {
  bf16_t lwa[4][32][72];
  float rkv[3][32][65];
  float lo[4][32][65];
  float invn[32];
  float seg[2][8][64];
  float cfp[32][65];
  bf16_t outt[2][4][32][64];
  bf16_t outv[32][64];
  float gt[2][64];
};
__device__ void ph_prep(const Params& p, int bid, int nb, unsigned char* smem) {
  PrepSmem& sm = *reinterpret_cast<PrepSmem*>(smem);
  const bf16_t* ZS = (const bf16_t*)((const unsigned char*)p.out + DO_ZS);
  const bf16_t* W2T = (const bf16_t*)(p.ws + WS_W2T);
  const bf16_t* A2T = (const bf16_t*)(p.ws + WS_A2T);
  unsigned char* TB = p.ws + WS_TB;
  bf16_t* VT = (bf16_t*)(p.ws + WS_VT);
  float* COEF = (float*)(p.ws + WS_COEF);
  int tid = threadIdx.x;
  asm volatile("" : "+v"(tid));
  const int lane = tid & 63, w = tid >> 6;
  const int tok = tid >> 4, cg = tid & 15;
  const int r31 = lane & 31, hh = lane >> 5;
  for (int it = bid; it < B_ * NCS * NH_; it += nb) {
    const int h = it & 7, bc = it >> 3;
    const int b = bc / NCS, cs = bc % NCS;
    const int isctx = cs < NCS_CTX;
    const int t0 = isctx ? cs * RT_ : (cs - NCS_CTX) * RT_;
    const int t = t0 + tok;
    const int m = isctx ? b * LC_ + t : NCTX + b * L_ + t;
    int nbr[4];
    if (isctx) {
      nbr[0] = nbr[2] = (t > 0) ? m - 1 : -1;
      nbr[1] = nbr[3] = (t < LC_ - 1) ? m + 1 : -1;
    } else {
      nbr[0] = ((t & 63) > 0) ? m - 1 : -1;
      nbr[1] = ((t & 63) < 63) ? m + 1 : -1;
      nbr[2] = (t >= 64) ? m - 64 : -1;
      nbr[3] = (t < L_ - 64) ? m + 64 : -1;
    }
    {
      const int cbase = 3 * DR_ + cg * 16;
      const bf16_t* own = ZS + (size_t)m * SW_ + cbase;
      uint4 o0 = *reinterpret_cast<const uint4*>(own), o1 = *reinterpret_cast<const uint4*>(own + 8);
      unsigned ow[8] = {o0.x, o0.y, o0.z, o0.w, o1.x, o1.y, o1.z, o1.w};
      float val[16];
#pragma unroll
      for (int i = 0; i < 8; ++i) { val[2 * i] = lo2f(ow[i]); val[2 * i + 1] = hi2f(ow[i]); }
      float nv[16];
#pragma unroll
      for (int i = 0; i < 16; ++i) nv[i] = 0.f;
#pragma unroll
      for (int s = 0; s < 4; ++s) {
        if (nbr[s] >= 0) {
          const bf16_t* np_ = ZS + (size_t)nbr[s] * SW_ + cbase;
          uint4 n0 = *reinterpret_cast<const uint4*>(np_), n1 = *reinterpret_cast<const uint4*>(np_ + 8);
          unsigned nw[8] = {n0.x, n0.y, n0.z, n0.w, n1.x, n1.y, n1.z, n1.w};
#pragma unroll
          for (int q = 0; q < 4; ++q) {
            const int col = q * 4 + s;
            nv[col] = (col & 1) ? hi2f(nw[col >> 1]) : lo2f(nw[col >> 1]);
          }
        }
      }
      const int which = cg >> 2;
      const int idx = (which & 1) * 2 + (which >> 1);
      const int cb = (cg & 3) * 16;
      float res[16];
#pragma unroll
      for (int i = 0; i < 16; ++i) {
        const float mu = p.mu[cbase + i];
        float v = val[i] + mu * (nv[i] - val[i]);
        if (which < 2) v = tanhf(v);
        res[i] = v;
      }
#pragma unroll
      for (int i = 0; i < 8; ++i) *reinterpret_cast<unsigned*>(&sm.lwa[idx][tok][cb + 2 * i]) = pack2(res[2 * i], res[2 * i + 1]);
    }
#pragma unroll
    for (int f = 0; f < 3; ++f) {
      const int cbase = f * DR_ + h * 64 + cg * 4;
      const uint2 o = *reinterpret_cast<const uint2*>(ZS + (size_t)m * SW_ + cbase);
      float val[4] = {lo2f(o.x), hi2f(o.x), lo2f(o.y), hi2f(o.y)};
      float nv[4] = {0.f, 0.f, 0.f, 0.f};
#pragma unroll
      for (int s = 0; s < 4; ++s) {
        if (nbr[s] >= 0) {
          const uint2 n = *reinterpret_cast<const uint2*>(ZS + (size_t)nbr[s] * SW_ + cbase);
          nv[s] = (s == 0) ? lo2f(n.x) : (s == 1) ? hi2f(n.x) : (s == 2) ? lo2f(n.y) : hi2f(n.y);
        }
      }
      float ss = 0.f;
#pragma unroll
      for (int i = 0; i < 4; ++i) {
        const float mu = p.mu[cbase + i];
        const float x = val[i] + mu * (nv[i] - val[i]);
        sm.rkv[f][tok][cg * 4 + i] = x;
        const float kkv = x * p.k_k[h * 64 + cg * 4 + i];
        ss += kkv * kkv;
      }
      if (f == 1) {
        ss = allreduce16(ss);
        if (cg == 0) sm.invn[tok] = 1.f / fmaxf(sqrtf(ss), 1e-12f);
      }
    }
    __syncthreads();
    {
      const int idx = w >> 1, nt = w & 1;
      const int d = idx >> 1, type = idx & 1;
      const bf16_t* W = (type == 0 ? W2T : A2T) + (size_t)d * 512 * 64 + (size_t)(h * 64 + nt * 32 + r31) * 64;
      f32x16 acc;
#pragma unroll
      for (int i = 0; i < 16; ++i) acc[i] = 0.f;
#pragma unroll
      for (int ks = 0; ks < 4; ++ks) {
        const bf16x8 af = *reinterpret_cast<const bf16x8*>(&sm.lwa[idx][r31][ks * 16 + hh * 8]);
        const bf16x8 wf = *reinterpret_cast<const bf16x8*>(W + ks * 16 + hh * 8);
        acc = __builtin_amdgcn_mfma_f32_32x32x16_bf16(af, wf, acc, 0, 0, 0);
      }
#pragma unroll
      for (int i = 0; i < 16; ++i) sm.lo[idx][(i & 3) + 8 * (i >> 2) + 4 * hh][nt * 32 + r31] = acc[i];
    }
    __syncthreads();
    {
      const int c = lane, sg = w, ch = h * 64 + c;
      const float k_k = p.k_k[ch], k_a = p.k_a[ch], r_k = p.r_k[ch];
      const float w0_[2] = {p.w0[ch], p.w0[DR_ + ch]}, a0_[2] = {p.a0[ch], p.a0[DR_ + ch]};
      float r_[4], v_[4], a_[4], lam[2][4], kd[2][4], bb[2][4];
#pragma unroll
      for (int i = 0; i < 4; ++i) {
        const int tk = sg * 4 + i;
        r_[i] = sm.rkv[0][tk][c];
        const float k_ = sm.rkv[1][tk][c];
        v_[i] = sm.rkv[2][tk][c];
        const float kk = k_ * k_k * sm.invn[tk];
        a_[i] = -kk;
#pragma unroll
        for (int d = 0; d < 2; ++d) {
          const float wl = w0_[d] + sm.lo[d * 2 + 0][tk][c];
          lam[d][i] = 0.6065306597126334f / (1.f + expf(-wl));
          const float al = 1.f / (1.f + expf(-(a0_[d] + sm.lo[d * 2 + 1][tk][c])));
          kd[d][i] = k_ * (1.f + (al - 1.f) * k_a);
          bb[d][i] = kk * al;
        }
        sm.cfp[tk][c] = r_[i] * 0.5f * (kd[0][i] + kd[1][i]) * r_k;
      }
      float p0[4], s1[4];
      p0[0] = lam[0][0]; p0[1] = p0[0] + lam[0][1]; p0[2] = p0[1] + lam[0][2]; p0[3] = p0[2] + lam[0][3];
      s1[3] = lam[1][3]; s1[2] = s1[3] + lam[1][2]; s1[1] = s1[2] + lam[1][1]; s1[0] = s1[1] + lam[1][0];
      sm.seg[0][sg][c] = p0[3];
      sm.seg[1][sg][c] = s1[0];
      __syncthreads();
      float off0 = 0.f, off1 = 0.f, tot0 = 0.f, tot1 = 0.f;
#pragma unroll
      for (int s = 0; s < 8; ++s) {
        const float e0 = sm.seg[0][s][c], e1 = sm.seg[1][s][c];
        tot0 += e0; tot1 += e1;
        if (s < sg) off0 += e0;
        if (s > sg) off1 += e1;
      }
      const int pc = pos_(c);
#pragma unroll
      for (int i = 0; i < 4; ++i) {
        const int tk = sg * 4 + i;
        {
          const float Lm = off0 + p0[i];
          const float eg = expf(-Lm), ei = expf(Lm), ep = expf(-(Lm - lam[0][i]));
          sm.outt[0][0][tk][pc] = (bf16_t)(pack2(a_[i] * ep, 0.f) & 0xffff);
          sm.outt[0][1][tk][pc] = (bf16_t)(pack2(r_[i] * eg, 0.f) & 0xffff);
          sm.outt[0][2][tk][pc] = (bf16_t)(pack2(bb[0][i] * ei, 0.f) & 0xffff);
          sm.outt[0][3][tk][pc] = (bf16_t)(pack2(kd[0][i] * ei, 0.f) & 0xffff);
        }
        {
          const float Lm = off1 + s1[i];
          const float eg = expf(-Lm), ei = expf(Lm), ep = expf(-(Lm - lam[1][i]));
          sm.outt[1][0][31 - tk][pc] = (bf16_t)(pack2(a_[i] * ep, 0.f) & 0xffff);
          sm.outt[1][1][31 - tk][pc] = (bf16_t)(pack2(r_[i] * eg, 0.f) & 0xffff);
          sm.outt[1][2][31 - tk][pc] = (bf16_t)(pack2(bb[1][i] * ei, 0.f) & 0xffff);
          sm.outt[1][3][31 - tk][pc] = (bf16_t)(pack2(kd[1][i] * ei, 0.f) & 0xffff);
        }
        sm.outv[tk][c] = (bf16_t)(pack2(v_[i], 0.f) & 0xffff);
      }
      if (sg == 0) { sm.gt[0][c] = expf(-tot0); sm.gt[1][c] = expf(-tot1); }
    }
    __syncthreads();
    {
#pragma unroll
      for (int i = 0; i < 4; ++i) {
        const int q = tid + i * 512;
        const int d = q >> 10, rem = q & 1023;
        unsigned char* rec = TB + ((size_t)((d * B_ + b) * NH_ + h) * NCS + cs) * TB_REC;
        *reinterpret_cast<uint4*>(rec + rem * 16) = *reinterpret_cast<const uint4*>(reinterpret_cast<const unsigned char*>(&sm.outt[d][0][0][0]) + rem * 16);
      }
      if (tid < 256) {
        *reinterpret_cast<uint4*>(reinterpret_cast<unsigned char*>(VT + ((size_t)(b * NH_ + h) * NCS + cs) * (RT_ * 64)) + tid * 16) =
            *reinterpret_cast<const uint4*>(reinterpret_cast<const unsigned char*>(&sm.outv[0][0]) + tid * 16);
      } else if (tid < 256 + 32) {
        const int q = tid - 256, d = q >> 4, j = q & 15;
        unsigned char* rec = TB + ((size_t)((d * B_ + b) * NH_ + h) * NCS + cs) * TB_REC;
        *reinterpret_cast<float4*>(rec + 4 * RT_ * 64 * 2 + j * 16) = *reinterpret_cast<const float4*>(&sm.gt[d][j * 4]);
      } else if (tid >= 320 && tid < 352 && !isctx) {
        const int tk = tid - 320;
        float s = 0.f;
        for (int c = 0; c < 64; ++c) s += sm.cfp[tk][c];
        COEF[((size_t)b * L_ + t0 + tk) * NH_ + h] = s;
      }
    }
    __syncthreads();
  }
}

constexpr int TS_ = 72;
constexpr int IS_ = 40;
struct ScanBuf {
  bf16_t at[32][TS_], rt[32][TS_], bt[32][TS_], kt[32][TS_];
  bf16_t btt[64][IS_], ktt[64][IS_], vtt[64][IS_];
  float gt[64];
};
struct ScanImg { bf16_t ti[32][IS_], lak[32][IS_], mrb[32][IS_], mrk[32][IS_]; };
struct ScanSmem { ScanBuf buf[3]; ScanImg img[2]; };
#define MFMA32(a, b, c) __builtin_amdgcn_mfma_f32_32x32x16_bf16((a), (b), (c), 0, 0, 0)
__device__ __forceinline__ bf16x8 cvt_frag(const f32x16& x, int s) {
  u32x4 pk;
  pk[0] = pack2(x[8 * s + 0], x[8 * s + 1]);
  pk[1] = pack2(x[8 * s + 2], x[8 * s + 3]);
  pk[2] = pack2(x[8 * s + 4], x[8 * s + 5]);
  pk[3] = pack2(x[8 * s + 6], x[8 * s + 7]);
  return __builtin_bit_cast(bf16x8, pk);
}
__device__ __forceinline__ void dump_img(bf16_t (*img)[IS_], const f32x16& x, int r, int hh) {
  *reinterpret_cast<bf16x8*>(&img[r][8 * hh]) = cvt_frag(x, 0);
  *reinterpret_cast<bf16x8*>(&img[r][16 + 8 * hh]) = cvt_frag(x, 1);
}
__device__ __forceinline__ f32x16 zero16() {
  f32x16 z;
#pragma unroll
  for (int i = 0; i < 16; ++i) z[i] = 0.f;
  return z;
}
__device__ __forceinline__ f32x16 pair_prod(const bf16_t (*X)[TS_], const bf16_t (*Y)[TS_], int r, int hh) {
  f32x16 c = zero16();
#pragma unroll
  for (int ks = 0; ks < 4; ++ks) {
    const bf16x8 a = *reinterpret_cast<const bf16x8*>(&X[r][16 * ks + 8 * hh]);
    const bf16x8 b = *reinterpret_cast<const bf16x8*>(&Y[r][16 * ks + 8 * hh]);
    c = MFMA32(a, b, c);
  }
  return c;
}
__device__ void ph_scan(const Params& p, int bid, int nb, unsigned char* smem) {
  ScanSmem& sm = *reinterpret_cast<ScanSmem*>(smem);
  const unsigned char* TB = p.ws + WS_TB;
  const bf16_t* VT = (const bf16_t*)(p.ws + WS_VT);
  bf16_t* Y = (bf16_t*)(p.ws + WS_Y);
  int tid = threadIdx.x;
  asm volatile("" : "+v"(tid));
  const int lane = tid & 63;
  const int wave = __builtin_amdgcn_readfirstlane(tid >> 6);
  const int r = lane & 31, hh = lane >> 5;
  for (int u = bid; u < 2 * B_ * NH_; u += nb) {
    const int h = u & 7, b = (u >> 3) & 7, d = u >> 6;
    const unsigned char* tb_base = TB + (size_t)((d * B_ + b) * NH_ + h) * NCS * TB_REC;
    const bf16_t* vt_base = VT + (size_t)(b * NH_ + h) * NCS * (RT_ * 64);
    f32x16 ST0 = zero16(), ST1 = zero16();
    for (int it = 0; it < NCS + 2; ++it) {
      if (wave >= 4) {
        if (it < NCS) {
          const int cs = (d == 0) ? it : ((it < NCS_CTX) ? (NCS_CTX - 1 - it) : (NCS + NCS_CTX - 1 - it));
          ScanBuf& B = sm.buf[it % 3];
          const int lt = tid - 256;
          const unsigned char* rec = tb_base + (size_t)cs * TB_REC;
          uint4 g[4];
#pragma unroll
          for (int i = 0; i < 4; ++i) g[i] = *reinterpret_cast<const uint4*>(rec + (size_t)(lt + 256 * i) * 16);
          const uint4 gv = *reinterpret_cast<const uint4*>(reinterpret_cast<const unsigned char*>(vt_base + (size_t)cs * (RT_ * 64)) + lt * 16);
          float4 gg;
          if (lt < 16) gg = *reinterpret_cast<const float4*>(rec + 4 * RT_ * 64 * 2 + lt * 16);
          const int row = (lt >> 3) & 31, cc = lt & 7;
          *reinterpret_cast<uint4*>(&B.at[row][cc * 8]) = g[0];
          *reinterpret_cast<uint4*>(&B.rt[row][cc * 8]) = g[1];
          *reinterpret_cast<uint4*>(&B.bt[row][cc * 8]) = g[2];
          *reinterpret_cast<uint4*>(&B.kt[row][cc * 8]) = g[3];
          const int prow = pos_(row);
          {
            const unsigned wb[4] = {g[2].x, g[2].y, g[2].z, g[2].w};
            const unsigned wk[4] = {g[3].x, g[3].y, g[3].z, g[3].w};
#pragma unroll
            for (int e = 0; e < 8; ++e) {
              const int kk = pos_(cc * 8 + e);
              B.btt[kk][prow] = (bf16_t)((e & 1) ? (wb[e >> 1] >> 16) : (wb[e >> 1] & 0xffff));
              B.ktt[kk][prow] = (bf16_t)((e & 1) ? (wk[e >> 1] >> 16) : (wk[e >> 1] & 0xffff));
            }
            const unsigned wv[4] = {gv.x, gv.y, gv.z, gv.w};
            const int ptau = pos_(d ? 31 - row : row);
#pragma unroll
            for (int e = 0; e < 8; ++e) B.vtt[cc * 8 + e][ptau] = (bf16_t)((e & 1) ? (wv[e >> 1] >> 16) : (wv[e >> 1] & 0xffff));
          }
          if (lt < 16) *reinterpret_cast<float4*>(&B.gt[lt * 4]) = gg;
        }
      } else if (wave == 2) {
        const int c1 = it - 1;
        if (c1 >= 0 && c1 < NCS) {
          const ScanBuf& B = sm.buf[c1 % 3];
          ScanImg& I = sm.img[c1 & 1];
          f32x16 Xc = pair_prod(B.at, B.bt, r, hh);
          f32x16 Xtc = pair_prod(B.bt, B.at, r, hh);
          f32x16 Ttc;
#pragma unroll
          for (int i = 0; i < 16; ++i) {
            const int row = (i & 3) + 8 * (i >> 2) + 4 * hh;
            Xc[i] = (r < row) ? Xc[i] : 0.f;
            Xtc[i] = (row < r) ? Xtc[i] : 0.f;
            Ttc[i] = Xtc[i] + ((row == r) ? 1.f : 0.f);
          }
#pragma unroll
          for (int n = 0; n < 4; ++n) {
            const bf16x8 xc0 = cvt_frag(Xc, 0), xc1 = cvt_frag(Xc, 1), xt0 = cvt_frag(Xtc, 0), xt1 = cvt_frag(Xtc, 1);
            f32x16 Xn = zero16();
            Xn = MFMA32(xt0, xc0, Xn);
            Xn = MFMA32(xt1, xc1, Xn);
            if (n < 3) {
              f32x16 Xtn = zero16();
              Xtn = MFMA32(xc0, xt0, Xtn);
              Xtn = MFMA32(xc1, xt1, Xtn);
              Xtc = Xtn;
            }
            const bf16x8 t0 = cvt_frag(Ttc, 0), t1 = cvt_frag(Ttc, 1);
            Ttc = MFMA32(cvt_frag(Xn, 0), t0, Ttc);
            Ttc = MFMA32(cvt_frag(Xn, 1), t1, Ttc);
            Xc = Xn;
          }
          dump_img(I.ti, Ttc, r, hh);
        }
      } else if (wave == 3) {
        const int c1 = it - 1;
        if (c1 >= 0 && c1 < NCS) {
          const ScanBuf& B = sm.buf[c1 % 3];
          ScanImg& I = sm.img[c1 & 1];
          f32x16 x = pair_prod(B.kt, B.at, r, hh);
#pragma unroll
          for (int i = 0; i < 16; ++i) { const int row = (i & 3) + 8 * (i >> 2) + 4 * hh; x[i] = (row < r) ? x[i] : 0.f; }
          dump_img(I.lak, x, r, hh);
          x = pair_prod(B.bt, B.rt, r, hh);
#pragma unroll
          for (int i = 0; i < 16; ++i) { const int row = (i & 3) + 8 * (i >> 2) + 4 * hh; x[i] = (row <= r) ? x[i] : 0.f; }
          dump_img(I.mrb, x, r, hh);
          x = pair_prod(B.kt, B.rt, r, hh);
#pragma unroll
          for (int i = 0; i < 16; ++i) { const int row = (i & 3) + 8 * (i >> 2) + 4 * hh; x[i] = (row <= r) ? x[i] : 0.f; }
          dump_img(I.mrk, x, r, hh);
        }
      } else {
        const int c2 = it - 2;
        if (c2 >= 0) {
          const int vt = wave;
          const ScanBuf& B = sm.buf[c2 % 3];
          const ScanImg& I = sm.img[c2 & 1];
          const bf16x8 sb00 = cvt_frag(ST0, 0), sb01 = cvt_frag(ST0, 1), sb10 = cvt_frag(ST1, 0), sb11 = cvt_frag(ST1, 1);
          const bf16x8 vf0 = *reinterpret_cast<const bf16x8*>(&B.vtt[vt * 32 + r][8 * hh]);
          const bf16x8 vf1 = *reinterpret_cast<const bf16x8*>(&B.vtt[vt * 32 + r][16 + 8 * hh]);
          f32x16 RHS = zero16();
          RHS = MFMA32(*reinterpret_cast<const bf16x8*>(&B.at[r][0 + 8 * hh]), sb00, RHS);
          RHS = MFMA32(*reinterpret_cast<const bf16x8*>(&B.at[r][16 + 8 * hh]), sb01, RHS);
          RHS = MFMA32(*reinterpret_cast<const bf16x8*>(&B.at[r][32 + 8 * hh]), sb10, RHS);
          RHS = MFMA32(*reinterpret_cast<const bf16x8*>(&B.at[r][48 + 8 * hh]), sb11, RHS);
          RHS = MFMA32(*reinterpret_cast<const bf16x8*>(&I.lak[r][8 * hh]), vf0, RHS);
          RHS = MFMA32(*reinterpret_cast<const bf16x8*>(&I.lak[r][16 + 8 * hh]), vf1, RHS);
          f32x16 U = zero16();
          U = MFMA32(*reinterpret_cast<const bf16x8*>(&I.ti[r][8 * hh]), cvt_frag(RHS, 0), U);
          U = MFMA32(*reinterpret_cast<const bf16x8*>(&I.ti[r][16 + 8 * hh]), cvt_frag(RHS, 1), U);
          const bf16x8 ub0 = cvt_frag(U, 0), ub1 = cvt_frag(U, 1);
          const int cs = (d == 0) ? c2 : ((c2 < NCS_CTX) ? (NCS_CTX - 1 - c2) : (NCS + NCS_CTX - 1 - c2));
          if (cs >= NCS_CTX) {
            f32x16 Yt = zero16();
            Yt = MFMA32(*reinterpret_cast<const bf16x8*>(&B.rt[r][0 + 8 * hh]), sb00, Yt);
            Yt = MFMA32(*reinterpret_cast<const bf16x8*>(&B.rt[r][16 + 8 * hh]), sb01, Yt);
            Yt = MFMA32(*reinterpret_cast<const bf16x8*>(&B.rt[r][32 + 8 * hh]), sb10, Yt);
            Yt = MFMA32(*reinterpret_cast<const bf16x8*>(&B.rt[r][48 + 8 * hh]), sb11, Yt);
            Yt = MFMA32(*reinterpret_cast<const bf16x8*>(&I.mrb[r][8 * hh]), ub0, Yt);
            Yt = MFMA32(*reinterpret_cast<const bf16x8*>(&I.mrb[r][16 + 8 * hh]), ub1, Yt);
            Yt = MFMA32(*reinterpret_cast<const bf16x8*>(&I.mrk[r][8 * hh]), vf0, Yt);
            Yt = MFMA32(*reinterpret_cast<const bf16x8*>(&I.mrk[r][16 + 8 * hh]), vf1, Yt);
            bf16_t* yb = Y + ((size_t)d * NLAT + (size_t)b * L_ + (cs - NCS_CTX) * RT_) * 512 + h * 64 + vt * 32 + r;
#pragma unroll
            for (int i = 0; i < 16; ++i) {
              const int tau = (i & 3) + 8 * (i >> 2) + 4 * hh;
              const int tk = d ? 31 - tau : tau;
              yb[(size_t)tk * 512] = (bf16_t)(pack2(Yt[i], 0.f) & 0xffff);
            }
          }
          ST0 = MFMA32(*reinterpret_cast<const bf16x8*>(&B.btt[r][8 * hh]), ub0, ST0);
          ST0 = MFMA32(*reinterpret_cast<const bf16x8*>(&B.btt[r][16 + 8 * hh]), ub1, ST0);
          ST0 = MFMA32(*reinterpret_cast<const bf16x8*>(&B.ktt[r][8 * hh]), vf0, ST0);
          ST0 = MFMA32(*reinterpret_cast<const bf16x8*>(&B.ktt[r][16 + 8 * hh]), vf1, ST0);
          ST1 = MFMA32(*reinterpret_cast<const bf16x8*>(&B.btt[32 + r][8 * hh]), ub0, ST1);
          ST1 = MFMA32(*reinterpret_cast<const bf16x8*>(&B.btt[32 + r][16 + 8 * hh]), ub1, ST1);
          ST1 = MFMA32(*reinterpret_cast<const bf16x8*>(&B.ktt[32 + r][8 * hh]), vf0, ST1);
          ST1 = MFMA32(*reinterpret_cast<const bf16x8*>(&B.ktt[32 + r][16 + 8 * hh]), vf1, ST1);
#pragma unroll
          for (int q = 0; q < 4; ++q) {
            const float4 g0 = *reinterpret_cast<const float4*>(&B.gt[8 * q + 4 * hh]);
            const float4 g1 = *reinterpret_cast<const float4*>(&B.gt[32 + 8 * q + 4 * hh]);
            ST0[4 * q + 0] *= g0.x; ST0[4 * q + 1] *= g0.y; ST0[4 * q + 2] *= g0.z; ST0[4 * q + 3] *= g0.w;
            ST1[4 * q + 0] *= g1.x; ST1[4 * q + 1] *= g1.y; ST1[4 * q + 2] *= g1.z; ST1[4 * q + 3] *= g1.w;
          }
        }
      }
      __syncthreads();
    }
  }
}

__device__ void ph_combine(const Params& p, int bid, int nb) {
  bf16_t* Y = (bf16_t*)(p.ws + WS_Y);
  const bf16_t* VT = (const bf16_t*)(p.ws + WS_VT);
  const bf16_t* GR = (const bf16_t*)(p.ws + WS_GR);
  const float* COEF = (const float*)(p.ws + WS_COEF);
  const int tid = opaque_tid();
  const int cg = tid & 15, grp = tid >> 4;
  for (int it = bid * 16 + grp; it < NLAT * NH_; it += nb * 16) {
    const int h = it & 7, m = it >> 3;
    const int b = m / L_, t = m % L_;
    const size_t off = (size_t)m * 512 + h * 64 + cg * 4;
    const uint2 yf = *reinterpret_cast<const uint2*>(Y + off);
    const uint2 yb = *reinterpret_cast<const uint2*>(Y + (size_t)NLAT * 512 + off);
    float y[4] = {lo2f(yf.x) + lo2f(yb.x), hi2f(yf.x) + hi2f(yb.x), lo2f(yf.y) + lo2f(yb.y), hi2f(yf.y) + hi2f(yb.y)};
    const float mean = allreduce16(y[0] + y[1] + y[2] + y[3]) * (1.f / 64.f);
    float vs = 0.f;
#pragma unroll
    for (int i = 0; i < 4; ++i) { y[i] -= mean; vs += y[i] * y[i]; }
    const float rstd = rsqrtf(allreduce16(vs) * (1.f / 64.f) + 64e-5f);
    const uint2 vv = *reinterpret_cast<const uint2*>(VT + ((size_t)(b * NH_ + h) * NCS + NCS_CTX + (t >> 5)) * (RT_ * 64) + (t & 31) * 64 + cg * 4);
    const float v_[4] = {lo2f(vv.x), hi2f(vv.x), lo2f(vv.y), hi2f(vv.y)};
    const uint2 gg = *reinterpret_cast<const uint2*>(GR + (size_t)(NCTX + m) * 512 + h * 64 + cg * 4);
    const float g_[4] = {lo2f(gg.x), hi2f(gg.x), lo2f(gg.y), hi2f(gg.y)};
    const float cf = COEF[(size_t)m * NH_ + h];
    float o[4];
#pragma unroll
    for (int i = 0; i < 4; ++i) {
      const int ch = h * 64 + cg * 4 + i;
      o[i] = (y[i] * rstd * p.lnx_g[ch] + p.lnx_b[ch] + cf * v_[i]) * siluf_(g_[i]);
    }
    uint2 ov;
    ov.x = pack2(o[0], o[1]);
    ov.y = pack2(o[2], o[3]);
    *reinterpret_cast<uint2*>(Y + off) = ov;
  }
}

struct AL_UChunk {
  const bf16_t* U;
  int m0, g, rows_per_b, chunk0;
  __device__ __forceinline__ uint4 load(int row, int k) const {
    const int mm = m0 + row;
    const int b = mm / rows_per_b, ch = chunk0 + mm % rows_per_b;
    const int s = k >> 4, c0 = k & 15;
    return *reinterpret_cast<const uint4*>(U + (size_t)tokrow(b, ch * 16 + s) * 512 + g * 16 + c0);
  }
};
struct EP_E {
  float* E;
  int m0, n0, g;
  __device__ __forceinline__ void operator()(f32x4 (&acc)[4][4], int wr, int wc, int lane) {
#pragma unroll
    for (int i = 0; i < 4; ++i)
#pragma unroll
      for (int j = 0; j < 4; ++j) {
        const int mm = m0 + wr * 64 + i * 16 + (lane & 15), n = n0 + wc * 64 + j * 16 + 4 * (lane >> 4);
        *reinterpret_cast<float4*>(E + ((size_t)mm * NG_ + g) * 256 + n) = make_float4(acc[i][j][0], acc[i][j][1], acc[i][j][2], acc[i][j][3]);
      }
  }
};
__device__ void ph_s5_e(const Params& p, int bid, int nb, unsigned char* smem) {
  const bf16_t* U = (const bf16_t*)(p.ws + WS_U);
  const bf16_t* G1 = (const bf16_t*)(p.ws + WS_G1);
  float* E = (float*)((unsigned char*)p.out + DO_E);
  constexpr int MT = (B_ * NCH_ALL) / 128;
  for (int t = bid; t < NG_ * MT * 2; t += nb) {
    const int nt = t & 1, mt = (t >> 1) % MT, g = (t >> 1) / MT;
    AL_UChunk al{U, mt * 128, g, NCH_ALL, 0};
    BL_Rows bl{G1 + ((size_t)g * 256 + nt * 128) * 256, 256};
    EP_E ep{E, mt * 128, nt * 128, g};
    gemm_tile(al, bl, ep, 256, smem);
  }
}

__device__ void ph_s5_carry(const Params& p, int bid, int nb) {
  float* E = (float*)((unsigned char*)p.out + DO_E);
  const float2* AP = (const float2*)(p.ws + WS_AP);
  for (int i = bid * 256 + opaque_tid(); i < B_ * NG_ * 2 * NP_; i += nb * 256) {
    const int pp = i & 63, d = (i >> 6) & 1, g = (i >> 7) & 31, b = i >> 12;
    const float2 a16 = AP[(size_t)((d * NG_ + g) * NP_ + pp) * 17 + 16];
    float hr = 0.f, hi = 0.f;
    float* base = E + ((size_t)b * NCH_ALL * NG_ + g) * 256 + d * 128 + pp;
    for (int s0 = 0; s0 < NCH_ALL; s0 += 16) {
      float er[16], ei[16];
#pragma unroll
      for (int j = 0; j < 16; ++j) {
        const int step = s0 + j;
        const int ch = (d == 0) ? step : ((step < NCH_CTX) ? (NCH_CTX - 1 - step) : (NCH_ALL + NCH_CTX - 1 - step));
        const float* e = base + (size_t)ch * NG_ * 256;
        er[j] = e[0]; ei[j] = e[64];
      }
#pragma unroll
      for (int j = 0; j < 16; ++j) {
        const int step = s0 + j;
        const int ch = (d == 0) ? step : ((step < NCH_CTX) ? (NCH_CTX - 1 - step) : (NCH_ALL + NCH_CTX - 1 - step));
        float* e = base + (size_t)ch * NG_ * 256;
        e[0] = hr; e[64] = hi;
        const float nr = a16.x * hr - a16.y * hi + er[j];
        const float ni = a16.x * hi + a16.y * hr + ei[j];
        hr = nr; hi = ni;
      }
    }
  }
}

struct AL_S5Out {
  const bf16_t* U;
  const float* E;
  int m0, g;
  __device__ __forceinline__ uint4 load(int row, int k) const {
    const int mm = m0 + row;
    const int b = mm >> 8, lc = mm & 255;
    if (k < 256) {
      const int s = k >> 4, c0 = k & 15;
      return *reinterpret_cast<const uint4*>(U + (size_t)(NCTX + b * L_ + lc * 16 + s) * 512 + g * 16 + c0);
    }
    const float* e = E + ((size_t)(b * NCH_ALL + NCH_CTX + lc) * NG_ + g) * 256 + (k - 256);
    const float4 e0 = *reinterpret_cast<const float4*>(e), e1 = *reinterpret_cast<const float4*>(e + 4);
    uint4 o;
    o.x = pack2(e0.x, e0.y); o.y = pack2(e0.z, e0.w); o.z = pack2(e1.x, e1.y); o.w = pack2(e1.z, e1.w);
    return o;
  }
};
struct EP_S5Out {
  const bf16_t* U;
  bf16_t* YS5;
  const float* dpar;
  int m0, n0, g;
  __device__ __forceinline__ void operator()(f32x4 (&acc)[4][4], int wr, int wc, int lane) {
#pragma unroll
    for (int i = 0; i < 4; ++i)
#pragma unroll
      for (int j = 0; j < 4; ++j) {
        const int mm = m0 + wr * 64 + i * 16 + (lane & 15), n = n0 + wc * 64 + j * 16 + 4 * (lane >> 4);
        const int b = mm >> 8, lc = mm & 255, sp = n >> 4, cp = n & 15;
        const size_t tok = (size_t)b * L_ + lc * 16 + sp;
        const uint2 uu = *reinterpret_cast<const uint2*>(U + (NCTX + tok) * 512 + g * 16 + cp);
        const float u_[4] = {lo2f(uu.x), hi2f(uu.x), lo2f(uu.y), hi2f(uu.y)};
        float o[4];
#pragma unroll
        for (int r = 0; r < 4; ++r) o[r] = gelu_tanh(acc[i][j][r] + dpar[g * 16 + cp + r] * u_[r]);
        uint2 ov;
        ov.x = pack2(o[0], o[1]);
        ov.y = pack2(o[2], o[3]);
        *reinterpret_cast<uint2*>(YS5 + tok * 512 + g * 16 + cp) = ov;
      }
  }
};
__device__ void ph_s5_out(const Params& p, int bid, int nb, unsigned char* smem) {
  const bf16_t* U = (const bf16_t*)(p.ws + WS_U);
  const bf16_t* G2 = (const bf16_t*)(p.ws + WS_G2);
  const float* E = (const float*)((const unsigned char*)p.out + DO_E);
  bf16_t* YS5 = (bf16_t*)((unsigned char*)p.out + DO_YS5);
  constexpr int MT = (B_ * 256) / 128;
  for (int t = bid; t < NG_ * MT * 2; t += nb) {
    const int nt = t & 1, mt = (t >> 1) % MT, g = (t >> 1) / MT;
    AL_S5Out al{U, E, mt * 128, g};
    BL_Rows bl{G2 + ((size_t)g * 256 + nt * 128) * 512, 512};
    EP_S5Out ep{U, YS5, p.s5_d, mt * 128, nt * 128, g};
    gemm_tile(al, bl, ep, 512, smem);
  }
}

struct AL_Rows {
  const bf16_t* base;
  int ld;
  __device__ __forceinline__ uint4 load(int row, int k) const { return *reinterpret_cast<const uint4*>(base + (size_t)row * ld + k); }
};
struct BL_Glu {
  const bf16_t* WT;
  int nb64;
  __device__ __forceinline__ uint4 load(int col, int k) const {
    const int wcj = col >> 6, jj = col & 63;
    const int n = (jj < 32) ? nb64 * 64 + wcj * 32 + jj : 512 + nb64 * 64 + wcj * 32 + (jj - 32);
    return *reinterpret_cast<const uint4*>(WT + (size_t)n * 512 + k);
  }
};
struct EP_Glu {
  const bf16_t* GS;
  bf16_t* YS;
  int nb64;
  __device__ __forceinline__ void operator()(f32x4 (&acc)[4][4], int wr, int wc, int lane) {
#pragma unroll
    for (int i = 0; i < 4; ++i)
#pragma unroll
      for (int jt = 0; jt < 2; ++jt) {
        const int row = wr * 64 + i * 16 + (lane & 15);
        const int ch = nb64 * 64 + wc * 32 + jt * 16 + 4 * (lane >> 4);
        const uint2 gg = *reinterpret_cast<const uint2*>(GS + (size_t)row * 512 + ch);
        const float g_[4] = {lo2f(gg.x), hi2f(gg.x), lo2f(gg.y), hi2f(gg.y)};
        float o[4];
#pragma unroll
        for (int r = 0; r < 4; ++r) o[r] = acc[i][jt][r] * sigmoidf_(acc[i][jt + 2][r]) * siluf_(g_[r]);
        uint2 ov;
        ov.x = pack2(o[0], o[1]);
        ov.y = pack2(o[2], o[3]);
        *reinterpret_cast<uint2*>(YS + (size_t)row * 512 + ch) = ov;
      }
  }
};
__device__ void ph_glu(const Params& p, int bid, int nb, unsigned char* smem) {
  const bf16_t* YS5 = (const bf16_t*)((const unsigned char*)p.out + DO_YS5);
  const bf16_t* WT = (const bf16_t*)(p.ws + WS_WGLUT);
  const bf16_t* GS = (const bf16_t*)(p.ws + WS_GS);
  bf16_t* YS = (bf16_t*)(p.ws + WS_U);
  for (int t = bid; t < (NLAT / 128) * 8; t += nb) {
    const int nbk = t & 7, mt = t >> 3;
    AL_Rows al{YS5 + (size_t)mt * 128 * 512, 512};
    BL_Glu bl{WT, nbk};
    EP_Glu ep{GS + (size_t)(NCTX + mt * 128) * 512, YS + (size_t)mt * 128 * 512, nbk};
    gemm_tile(al, bl, ep, 512, smem);
  }
}

struct AL_Cat {
  const bf16_t* YR;
  const bf16_t* YS;
  __device__ __forceinline__ uint4 load(int row, int k) const {
    return (k < 512) ? *reinterpret_cast<const uint4*>(YR + (size_t)row * 512 + k) : *reinterpret_cast<const uint4*>(YS + (size_t)row * 512 + (k - 512));
  }
};
struct EP_Out {
  const float* x;
  float* out;
  const float* gate;
  float* rowss;
  __device__ __forceinline__ void operator()(f32x4 (&acc)[4][4], int wr, int wc, int lane) {
#pragma unroll
    for (int i = 0; i < 4; ++i) {
      const int row = wr * 64 + i * 16 + (lane & 15);
      float ss = 0.f;
#pragma unroll
      for (int j = 0; j < 4; ++j) {
        const int col = wc * 64 + j * 16 + 4 * (lane >> 4);
        const float4 xv = *reinterpret_cast<const float4*>(x + (size_t)row * D_ + col);
        const float4 gv = *reinterpret_cast<const float4*>(gate + col);
        float4 o;
        o.x = xv.x + gv.x * acc[i][j][0];
        o.y = xv.y + gv.y * acc[i][j][1];
        o.z = xv.z + gv.z * acc[i][j][2];
        o.w = xv.w + gv.w * acc[i][j][3];
        ss += o.x * o.x + o.y * o.y + o.z * o.z + o.w * o.w;
        *reinterpret_cast<float4*>(out + (size_t)row * D_ + col) = o;
      }
      ss += __shfl_xor(ss, 16);
      ss += __shfl_xor(ss, 32);
      if (lane < 16) atomicAdd(rowss + row, ss);
    }
  }
};
__device__ void ph_out(const Params& p, int bid, int nb, unsigned char* smem) {
  const bf16_t* YR = (const bf16_t*)(p.ws + WS_Y);
  const bf16_t* YS = (const bf16_t*)(p.ws + WS_U);
  const bf16_t* WT = (const bf16_t*)(p.ws + WS_WOUTT);
  const float* MOD = (const float*)(p.ws + WS_MOD);
  float* ROWSS = (float*)(p.ws + WS_ROWSS);
  for (int t = bid; t < (NLAT / 128) * 8; t += nb) {
    const int nt = t & 7, mt = t >> 3;
    const int m0 = mt * 128, n0 = nt * 128, b = m0 / L_;
    AL_Cat al{YR + (size_t)m0 * 512, YS + (size_t)m0 * 512};
    BL_Rows bl{WT + (size_t)n0 * 1024, 1024};
    EP_Out ep{p.x + (size_t)m0 * D_ + n0, p.out + (size_t)m0 * D_ + n0, MOD + b * 3072 + 2048 + n0, ROWSS + m0};
    gemm_tile(al, bl, ep, 1024, smem);
  }
}

__device__ void ph_final(const Params& p, int bid, int nb) {
  const float* ROWSS = (const float*)(p.ws + WS_ROWSS);
  const int tid = opaque_tid();
  const int lane = tid & 63, w = tid >> 6;
  for (int m = bid * 4 + w; m < NLAT; m += nb * 4) {
    const float r = rsqrtf(ROWSS[m] * (1.f / D_) + 1e-6f);
    float* row = p.out + (size_t)m * D_;
#pragma unroll
    for (int i = 0; i < 4; ++i) {
      float4 v = *reinterpret_cast<float4*>(row + i * 256 + lane * 4);
      const float4 g = *reinterpret_cast<const float4*>(p.final_g + i * 256 + lane * 4);
      v.x *= r * g.x; v.y *= r * g.y; v.z *= r * g.z; v.w *= r * g.w;
      *reinterpret_cast<float4*>(row + i * 256 + lane * 4) = v;
    }
  }
}

#define XB_TMO      128
#define XB_XCNT(j)  (256  + 64 * (j))
#define XB_XSUB(j)  (1280 + 64 * (j))
#define XB_XGEN(j)  (2304 + 64 * (j))
#define XB_TOP      3328
#define XB_TOPGEN   3392
#define XCD_BAR_WORDS 3456
#define XB_SPIN_CAP (1u << 22)
#define LAS __attribute__((address_space(3)))
__device__ __forceinline__ unsigned xb_ld(unsigned* p) { return __hip_atomic_load(p, __ATOMIC_RELAXED, __HIP_MEMORY_SCOPE_AGENT); }
__device__ __forceinline__ unsigned xb_add(unsigned* p, unsigned v) { return __hip_atomic_fetch_add(p, v, __ATOMIC_RELAXED, __HIP_MEMORY_SCOPE_AGENT); }
__device__ __forceinline__ unsigned xb_xcc_id() { return (unsigned)__builtin_amdgcn_s_getreg((3 << 11) | 20) & 0xFu; }
#define XB_SPIN(cond, bar) do { unsigned _sp = 0; while (cond) { __builtin_amdgcn_s_sleep(1); \
    if ((++_sp & 255u) == 0u) { if (xb_ld(&(bar)[XB_TMO])) break; if (_sp > XB_SPIN_CAP) { atomicAdd(&(bar)[XB_TMO], 1u); break; } } } } while (0)
struct XcdBarrier { unsigned* bar; unsigned x; volatile LAS unsigned* st; };
__device__ __forceinline__ XcdBarrier xcd_barrier_post(unsigned* bar, volatile LAS unsigned* st) {
  XcdBarrier b; b.bar = bar; b.x = xb_xcc_id(); b.st = st;
  if (threadIdx.x == 0) (void)xb_add(&bar[XB_XCNT(b.x)], 1u);
  return b;
}
__device__ __forceinline__ void xcd_barrier_complete(unsigned* bar, unsigned x, unsigned& nloc, unsigned& nx) {
  const unsigned G = gridDim.x * gridDim.y * gridDim.z;
  unsigned sum, cnt, mine, sp = 0u;
  for (;;) {
    sum = 0u; cnt = 0u; mine = 0u;
#pragma unroll
    for (unsigned j = 0; j < 16; ++j) { const unsigned c = xb_ld(&bar[XB_XCNT(j)]); sum += c; cnt += (c > 0u) ? 1u : 0u; mine = (j == x) ? c : mine; }
    if (sum == G) break;
    __builtin_amdgcn_s_sleep(1);
    if ((++sp & 255u) == 0u) { if (xb_ld(&bar[XB_TMO])) break; if (sp > XB_SPIN_CAP) { atomicAdd(&bar[XB_TMO], 1u); break; } }
  }
  nloc = mine > 0u ? mine : 1u; nx = cnt > 0u ? cnt : 1u;
}
__device__ __forceinline__ void xcd_barrier(const XcdBarrier& b) {
  asm volatile("s_waitcnt vmcnt(0)" ::: "memory");
  __syncthreads();
  if (threadIdx.x == 0) {
    unsigned* bar = b.bar;
    __builtin_amdgcn_s_waitcnt(0);
    unsigned nloc = b.st[0], nx = b.st[1];
    if (nloc == 0u) { xcd_barrier_complete(bar, b.x, nloc, nx); b.st[0] = nloc; b.st[1] = nx; }
    const unsigned old = xb_add(&bar[XB_XSUB(b.x)], 1u);
    const unsigned gen = old / nloc;
    if (old + 1u == (gen + 1u) * nloc) {
      __builtin_amdgcn_fence(__ATOMIC_RELEASE, "agent");
      asm volatile("s_waitcnt vmcnt(0)" ::: "memory");
      const unsigned og = xb_add(&bar[XB_TOP], 1u);
      const unsigned tg = og / nx;
      if (og + 1u == (tg + 1u) * nx) xb_add(&bar[XB_TOPGEN], 1u);
      else XB_SPIN(xb_ld(&bar[XB_TOPGEN]) == tg, bar);
      __builtin_amdgcn_fence(__ATOMIC_ACQUIRE, "agent");
      xb_add(&bar[XB_XGEN(b.x)], 1u);
      asm volatile("s_waitcnt vmcnt(0)" ::: "memory");
    } else {
      XB_SPIN(xb_ld(&bar[XB_XGEN(b.x)]) == gen, bar);
      __builtin_amdgcn_fence(__ATOMIC_ACQUIRE, "agent");
      asm volatile("s_waitcnt vmcnt(0)" ::: "memory");
    }
  }
  __syncthreads();
}

constexpr int SUB_SMEM = 49152;
constexpr int SMEM_WORK = 126976;
constexpr int SMEM_BYTES = SMEM_WORK + 16;
static_assert(sizeof(ScanSmem) <= SMEM_WORK && sizeof(GemmSmem) <= SUB_SMEM && sizeof(PrepSmem) <= SMEM_WORK && 2 * SUB_SMEM <= SMEM_WORK, "LDS budget");

__global__ void __launch_bounds__(512, 2) mega_fwd(Params p) {
  extern __shared__ __attribute__((aligned(16))) unsigned char smem[];
  volatile LAS unsigned* st = (volatile LAS unsigned*)(smem + SMEM_WORK);
  if (threadIdx.x < 4) st[threadIdx.x] = 0u;
  __syncthreads();
  XcdBarrier bar = xcd_barrier_post((unsigned*)(p.ws + WS_CTL), st);
  const int sub = threadIdx.x >> 8;
  const int bid = blockIdx.x * 2 + sub, nb = gridDim.x * 2;
  unsigned char* ssm = smem + sub * SUB_SMEM;
  ph_mod(p, bid, nb);
  ph_transpose(p, bid, nb, ssm);
  ph_rs(p, bid, nb);
  ph_s5_ap(p, bid, nb);
  xcd_barrier(bar);
  ph_gmsh(p, bid, nb);
  ph_s5_kt(p, bid, nb);
  xcd_barrier(bar);
  ph_s5_g(p, bid, nb);
  ph_gemm1(p, bid, nb, ssm);
  xcd_barrier(bar);
  ph_prep(p, blockIdx.x, gridDim.x, smem);
  xcd_barrier(bar);
  ph_s5_e(p, bid, nb, ssm);
  xcd_barrier(bar);
  ph_s5_carry(p, bid, nb);
  xcd_barrier(bar);
  ph_s5_out(p, bid, nb, ssm);
  xcd_barrier(bar);
  ph_glu(p, bid, nb, ssm);
  xcd_barrier(bar);
  ph_scan(p, blockIdx.x, gridDim.x, smem);
  xcd_barrier(bar);
  ph_combine(p, bid, nb);
  xcd_barrier(bar);
  ph_out(p, bid, nb, ssm);
  xcd_barrier(bar);
  ph_final(p, bid, nb);
}

extern "C" void kernel_launch(void* const* d_in, const int* in_sizes, int n_in, void* d_out, int out_size, void* d_ws, size_t ws_size, hipStream_t stream) {
  (void)in_sizes; (void)n_in; (void)out_size;
  if (ws_size < WS_END) return;
  static int grid = 0;
  if (grid == 0) {
    int dev = 0, cus = 0, per_cu = 0;
    (void)hipGetDevice(&dev);
    (void)hipDeviceGetAttribute(&cus, hipDeviceAttributeMultiprocessorCount, dev);
    (void)hipFuncSetAttribute((const void*)mega_fwd, hipFuncAttributeMaxDynamicSharedMemorySize, SMEM_BYTES);
    (void)hipOccupancyMaxActiveBlocksPerMultiprocessor(&per_cu, (const void*)mega_fwd, 512, SMEM_BYTES);
    if (per_cu > 1) per_cu = 1;
    if (per_cu < 1) per_cu = 1;
    grid = cus * per_cu;
  }
  Params p{};
  const float** f = reinterpret_cast<const float**>(&p);
  for (int i = 0; i < 29; ++i) f[i] = (const float*)d_in[i];
  p.out = (float*)d_out;
  p.ws = (unsigned char*)d_ws;
  (void)hipMemsetAsync((char*)d_ws + WS_CTL, 0, WS_ZERO_END - WS_CTL, stream);
  void* args[] = {&p};
  (void)hipLaunchCooperativeKernel((const void*)mega_fwd, dim3(grid), dim3(512), args, SMEM_BYTES, stream);
}
```
